# Optimizing an MI355X kernel written in HIP

```python
import math
import jax, jax.numpy as jnp
from jax import lax
import numpy as np

D_MODEL = 1024
BATCH = 16
SEQ = 2048
DEPTH = 1

PLE_DIM = 256
GRID_W = 64
MIX_WIDTH = D_MODEL
HY_WIDTH = MIX_WIDTH // 2
NA_WIDTH = MIX_WIDTH - HY_WIDTH
NA_HEADS = 8
NA_HEAD_DIM = NA_WIDTH // NA_HEADS
HY_ORDER = 2
SHORT_CONV = 3
FILTER_EMB = 33
FILTER_BANDS = (FILTER_EMB - 1) // 2
FILTER_HIDDEN = 64
DECAY_TARGET = 1e-2
FAST_DECAY_PCT = 0.3
SLOW_DECAY_PCT = 1.5
WIN_ROWS = 8
WIN_COLS = 16
Q_ROWS = 2
Q_COLS = 16
N_GROUPS = 4
EXPERTS_PER_GROUP = 8
N_EXPERTS = N_GROUPS * EXPERTS_PER_GROUP
TOP_K = 2
D_EXPERT = D_MODEL // 2
MOE_BLOCK = 256
EPS = 1e-6
NEG_INF = -1e30
HY_COLS = (HY_ORDER + 1) * HY_WIDTH
IN_COLS = HY_COLS + 3 * NA_WIDTH

kernel_name = 'hybrid_hyena_natten_hiermoe_block'


def _rmsnorm(x, g):
    xf = x.astype(jnp.float32)
    y = xf * lax.rsqrt(jnp.mean(xf * xf, axis=-1, keepdims=True) + EPS)
    return (y * g.astype(jnp.float32)).astype(x.dtype)


def _short_conv(u, w, b):
    L = u.shape[1]
    pad = SHORT_CONV // 2
    up = jnp.pad(u, ((0, 0), (pad, SHORT_CONV - 1 - pad), (0, 0)))
    out = b
    for j in range(SHORT_CONV):
        out = out + up[:, j:j + L] * w[j]
    return out


def _hyena_filters(L, w1, b1, f1, w2, b2, f2, w3):
    f32 = jnp.float32
    t = jnp.linspace(0.0, 1.0, L, dtype=f32)[:, None]
    w = 2.0 * math.pi * jnp.arange(L, dtype=f32)[:, None] / L
    bands = jnp.linspace(1e-4, FILTER_BANDS - 1, FILTER_BANDS, dtype=f32)[None, :]
    z = jnp.concatenate([t, jnp.cos(bands * w), -jnp.sin(bands * w)], axis=-1)
    hid = jnp.sin(f1.astype(f32) * (z @ w1.astype(f32) + b1.astype(f32)))
    hid = jnp.sin(f2.astype(f32) * (hid @ w2.astype(f32) + b2.astype(f32)))
    hf = (hid @ w3.astype(f32)).reshape(L, 2, HY_ORDER, HY_WIDTH)
    max_decay = math.log(DECAY_TARGET) / FAST_DECAY_PCT
    min_decay = math.log(DECAY_TARGET) / SLOW_DECAY_PCT
    deltas = jnp.linspace(min_decay, max_decay, HY_WIDTH, dtype=f32)
    decay = jnp.exp(-t * jnp.abs(deltas)[None, :])
    hf = hf * decay[:, None, None, :]
    fwd, bwd = hf[:, 0], hf[:, 1]
    k = jnp.concatenate([fwd, jnp.zeros_like(fwd[:1]), bwd[:0:-1]], axis=0)
    return jnp.fft.rfft(k, axis=0)


def _hyena(u, conv_w, conv_b, filt_fft, skip):
    L = u.shape[1]
    u = _short_conv(u, conv_w, conv_b).astype(jnp.float32)
    x1, x2, v = jnp.split(u, 3, axis=-1)
    z = v
    for o, gate in enumerate((x1, x2)):
        zf = jnp.fft.rfft(z, n=2 * L, axis=1)
        conv = jnp.fft.irfft(zf * filt_fft[:, o][None], n=2 * L, axis=1)[:, :L]
        z = gate * (conv + z * skip[o].astype(jnp.float32))
    return z


def _natten_tables(rows):
    kr = min(WIN_ROWS, rows)
    krb = min(Q_ROWS + kr - 1, rows)
    kcb = min(Q_COLS + WIN_COLS - 1, GRID_W)
    npr, ncb = rows // Q_ROWS, GRID_W // Q_COLS
    rs = np.clip(np.arange(rows) - kr // 2, 0, rows - kr)
    cs = np.clip(np.arange(GRID_W) - WIN_COLS // 2, 0, GRID_W - WIN_COLS)
    q_r = np.arange(npr)[:, None] * Q_ROWS + np.arange(Q_ROWS)
    q_c = np.arange(ncb)[:, None] * Q_COLS + np.arange(Q_COLS)
    k_r = np.minimum(rs[q_r[:, 0]], rows - krb)[:, None] + np.arange(krb)
    k_c = np.minimum(cs[q_c[:, 0]], GRID_W - kcb)[:, None] + np.arange(kcb)
    nq, nk = Q_ROWS * Q_COLS, krb * kcb
    qr = np.broadcast_to(q_r[:, None, :, None], (npr, ncb, Q_ROWS, Q_COLS)).reshape(npr, ncb, nq, 1)
    qc = np.broadcast_to(q_c[None, :, None, :], (npr, ncb, Q_ROWS, Q_COLS)).reshape(npr, ncb, nq, 1)
    kr_ = np.broadcast_to(k_r[:, None, :, None], (npr, ncb, krb, kcb)).reshape(npr, ncb, 1, nk)
    kc_ = np.broadcast_to(k_c[None, :, None, :], (npr, ncb, krb, kcb)).reshape(npr, ncb, 1, nk)
    key_idx = (kr_ * GRID_W + kc_)[:, :, 0, :].astype(np.int32)
    valid = ((kr_ >= rs[qr]) & (kr_ < rs[qr] + kr)
             & (kc_ >= cs[qc]) & (kc_ < cs[qc] + WIN_COLS))
    dr = np.clip(kr_ - qr + WIN_ROWS - 1, 0, 2 * WIN_ROWS - 2).astype(np.int32)
    dc = np.clip(kc_ - qc + WIN_COLS - 1, 0, 2 * WIN_COLS - 2).astype(np.int32)
    return key_idx, valid, dr, dc


def _natten(qkv, rpb):
    B, L, _ = qkv.shape
    rows = L // GRID_W
    npr, ncb = rows // Q_ROWS, GRID_W // Q_COLS
    key_idx, valid, dr, dc = _natten_tables(rows)
    q, k, v = jnp.split(qkv, 3, axis=-1)
    q = q.reshape(B, npr, Q_ROWS, ncb, Q_COLS, NA_HEADS, NA_HEAD_DIM)
    q = q.transpose(0, 1, 3, 2, 4, 5, 6).reshape(B, npr, ncb, Q_ROWS * Q_COLS, NA_HEADS, NA_HEAD_DIM)
    k = k.reshape(B, L, NA_HEADS, NA_HEAD_DIM)
    v = v.reshape(B, L, NA_HEADS, NA_HEAD_DIM)
    kb = jnp.take(k, key_idx, axis=1)
    vb = jnp.take(v, key_idx, axis=1)
    s = jnp.einsum('bpjqhd,bpjkhd->bhpjqk', q, kb).astype(jnp.float32) * (NA_HEAD_DIM ** -0.5)
    bias = rpb.astype(jnp.float32)[:, dr, dc]
    s = jnp.where(valid, s + bias, NEG_INF)
    a = jax.nn.softmax(s, axis=-1).astype(vb.dtype)
    o = jnp.einsum('bhpjqk,bpjkhd->bpjqhd', a, vb)
    o = o.reshape(B, npr, ncb, Q_ROWS, Q_COLS, NA_WIDTH).transpose(0, 1, 3, 2, 4, 5)
    return o.reshape(B, L, NA_WIDTH)


def _moe(x, wg, bg, we, be, w1, w3, w2):
    B, L, D = x.shape
    T = B * L
    f32 = jnp.float32
    xf = x.reshape(T, D)
    xr = xf.astype(f32)
    g_prob = jax.nn.softmax(xr @ wg.astype(f32) + bg.astype(f32), axis=-1)
    g_w, g_idx = lax.top_k(g_prob, 1)
    e_logits = (xr @ we.astype(f32) + be.astype(f32)).reshape(T, N_GROUPS, EXPERTS_PER_GROUP)
    e_logits = jnp.take_along_axis(e_logits, g_idx[:, :, None], axis=1)[:, 0]
    e_w, e_idx = lax.top_k(jax.nn.softmax(e_logits, axis=-1), TOP_K)
    gates = g_w * (e_w / jnp.sum(e_w, axis=-1, keepdims=True))
    ids = (g_idx * EXPERTS_PER_GROUP + e_idx).astype(jnp.int32)
    A = T * TOP_K
    flat = ids.reshape(-1)
    order = jnp.argsort(flat)
    sid = flat[order]
    tok = (order // TOP_K).astype(jnp.int32)
    gate_s = gates.reshape(-1)[order]
    counts = jnp.bincount(flat, length=N_EXPERTS)
    padded = (counts + MOE_BLOCK - 1) // MOE_BLOCK * MOE_BLOCK
    pad_end = jnp.cumsum(padded)
    pad_start = pad_end - padded
    seg_start = jnp.cumsum(counts) - counts
    dest = pad_start[sid] + jnp.arange(A, dtype=jnp.int32) - seg_start[sid]
    n_blocks = -(-(A + N_EXPERTS * (MOE_BLOCK - 1)) // MOE_BLOCK)
    slot_tok = jnp.full((n_blocks * MOE_BLOCK,), T, jnp.int32).at[dest].set(tok)
    block_e = jnp.minimum(jnp.searchsorted(pad_end, jnp.arange(n_blocks) * MOE_BLOCK, side='right'), N_EXPERTS - 1)
    xpad = jnp.concatenate([xf, jnp.zeros((1, D), xf.dtype)], axis=0)
    xb = xpad[slot_tok].reshape(n_blocks, MOE_BLOCK, D)

    def expert_block(args):
        xblk, e = args
        hid = jax.nn.silu(xblk @ w1[e]) * (xblk @ w3[e])
        return hid @ w2[e]

    yb = lax.map(expert_block, (xb, block_e)).reshape(-1, D)
    y = jnp.zeros((T, D), x.dtype).at[tok].add(yb[dest] * gate_s[:, None].astype(x.dtype))
    return y.reshape(B, L, D)


def setup_inputs(seed: int = 0) -> dict:
    key = jax.random.key(seed)
    ks = jax.random.split(key, 32)
    n = jax.random.normal
    f32 = jnp.float32

    def gain(k, shape):
        return 1.0 + 0.01 * n(k, shape, f32)

    return {
        'x': n(ks[0], (BATCH, SEQ, D_MODEL), f32),
        'p': n(ks[1], (DEPTH, BATCH, SEQ, PLE_DIM), f32),
        'g_mix': gain(ks[2], (DEPTH, D_MODEL)),
        'w_in': n(ks[3], (DEPTH, D_MODEL, IN_COLS), f32) * D_MODEL ** -0.5,
        'hy_conv_w': n(ks[4], (DEPTH, SHORT_CONV, HY_COLS), f32) * SHORT_CONV ** -0.5,
        'hy_conv_b': 0.01 * n(ks[5], (DEPTH, HY_COLS), f32),
        'hy_f_w1': n(ks[6], (DEPTH, FILTER_EMB, FILTER_HIDDEN), f32) * FILTER_EMB ** -0.5,
        'hy_f_b1': 0.01 * n(ks[7], (DEPTH, FILTER_HIDDEN), f32),
        'hy_f_freq1': gain(ks[8], (DEPTH, FILTER_HIDDEN)),
        'hy_f_w2': n(ks[9], (DEPTH, FILTER_HIDDEN, FILTER_HIDDEN), f32) * FILTER_HIDDEN ** -0.5,
        'hy_f_b2': 0.01 * n(ks[10], (DEPTH, FILTER_HIDDEN), f32),
        'hy_f_freq2': gain(ks[11], (DEPTH, FILTER_HIDDEN)),
        'hy_f_w3': n(ks[12], (DEPTH, FILTER_HIDDEN, 2 * HY_ORDER * HY_WIDTH), f32) * (0.1 * FILTER_HIDDEN ** -0.5),
        'hy_skip': n(ks[13], (DEPTH, HY_ORDER, HY_WIDTH), f32),
        'na_rpb': 0.02 * n(ks[14], (DEPTH, NA_HEADS, 2 * WIN_ROWS - 1, 2 * WIN_COLS - 1), f32),
        'g_out_hy': gain(ks[15], (DEPTH, HY_WIDTH)),
        'g_out_na': gain(ks[16], (DEPTH, NA_WIDTH)),
        'w_out': n(ks[17], (DEPTH, MIX_WIDTH, D_MODEL), f32) * MIX_WIDTH ** -0.5,
        'g_ffn': gain(ks[18], (DEPTH, D_MODEL)),
        'router_wg': n(ks[19], (DEPTH, D_MODEL, N_GROUPS), f32) * D_MODEL ** -0.5,
        'router_bg': 0.01 * n(ks[20], (DEPTH, N_GROUPS), f32),
        'router_we': n(ks[21], (DEPTH, D_MODEL, N_EXPERTS), f32) * D_MODEL ** -0.5,
        'router_be': 0.01 * n(ks[22], (DEPTH, N_EXPERTS), f32),
        'exp_w1': n(ks[23], (DEPTH, N_EXPERTS, D_MODEL, D_EXPERT), f32) * D_MODEL ** -0.5,
        'exp_w3': n(ks[24], (DEPTH, N_EXPERTS, D_MODEL, D_EXPERT), f32) * D_MODEL ** -0.5,
        'exp_w2': n(ks[25], (DEPTH, N_EXPERTS, D_EXPERT, D_MODEL), f32) * D_EXPERT ** -0.5,
        'g_ple': gain(ks[26], (DEPTH, D_MODEL)),
        'w_ple_gate': n(ks[27], (DEPTH, D_MODEL, D_MODEL), f32) * D_MODEL ** -0.5,
        'w_ple_proj': n(ks[28], (DEPTH, PLE_DIM, D_MODEL), f32) * PLE_DIM ** -0.5,
        'g_final': gain(ks[29], (D_MODEL,)),
    }


def reference(x, p, g_mix, w_in, hy_conv_w, hy_conv_b, hy_f_w1, hy_f_b1, hy_f_freq1, hy_f_w2, hy_f_b2,
              hy_f_freq2, hy_f_w3, hy_skip, na_rpb, g_out_hy, g_out_na, w_out, g_ffn, router_wg, router_bg,
              router_we, router_be, exp_w1, exp_w3, exp_w2, g_ple, w_ple_gate, w_ple_proj, g_final):
    L = x.shape[1]
    h = x
    for i in range(DEPTH):
        u = _rmsnorm(h, g_mix[i]) @ w_in[i]
        filt = _hyena_filters(L, hy_f_w1[i], hy_f_b1[i], hy_f_freq1[i], hy_f_w2[i], hy_f_b2[i],
                              hy_f_freq2[i], hy_f_w3[i])
        y_hy = _hyena(u[..., :HY_COLS], hy_conv_w[i], hy_conv_b[i], filt, hy_skip[i])
        y_na = _natten(u[..., HY_COLS:], na_rpb[i])
        mixed = jnp.concatenate([_rmsnorm(y_hy, g_out_hy[i]).astype(h.dtype),
                                 _rmsnorm(y_na, g_out_na[i]).astype(h.dtype)], axis=-1)
        h = h + mixed @ w_out[i]
        h = h + _moe(_rmsnorm(h, g_ffn[i]), router_wg[i], router_bg[i], router_we[i], router_be[i],
                     exp_w1[i], exp_w3[i], exp_w2[i])
        gate = jax.nn.sigmoid(_rmsnorm(h, g_ple[i]) @ w_ple_gate[i])
        h = h + (p[i] @ w_ple_proj[i]) * gate
    return _rmsnorm(h, g_final)
```

```cpp
#define MK_N_LAUNCHES 0
#include <hip/hip_runtime.h>
#include <cstdio>
#include <cstdint>
#ifndef MK_N_LAUNCHES
#define MK_N_LAUNCHES 1
#endif
#ifndef HY_NAIVE
#define HY_NAIVE 1
#endif
#ifndef NA_NAIVE
#define NA_NAIVE 1
#endif
#ifndef RT_NAIVE
#define RT_NAIVE 1
#endif
#ifndef MOE_NAIVE
#define MOE_NAIVE 1
#endif
namespace pg8 {
#define PG8_LAS __attribute__((address_space(3)))
typedef unsigned short bf16_t;
typedef short bf16x8 __attribute__((ext_vector_type(8)));
typedef float f32x4 __attribute__((ext_vector_type(4)));
typedef float f32x2 __attribute__((ext_vector_type(2)));
typedef unsigned u32x4 __attribute__((ext_vector_type(4)));
typedef unsigned u32x2 __attribute__((ext_vector_type(2)));
constexpr int BM = 256, BK = 64, HALF = 128, HTB = HALF * BK * 2  , STAGE_BYTES = 8 * HTB, NXCD = 8, WGM = 8;

__host__ __device__ __forceinline__ int lds_byte(int r, int c) { const int st = (r >> 4) * 2 + (c >> 5), rr = r & 15, cc = c & 31, ob = rr * 64 + cc * 2; return st * 1024 + (ob ^ (((ob >> 9) & 1) << 5)); }
__host__ __device__ __forceinline__ void stage_rc(int b, int& R, int& C) { const int st = b / 1024, sb = b % 1024, swz = sb ^ (((sb >> 9) & 1) << 5); R = (st >> 1) * 16 + swz / 64; C = (st & 1) * 32 + (swz % 64) / 2; }
__host__ __device__ __forceinline__ int perm32(int rho) { const int n = rho >> 4, i = rho & 15; return 8 * (i >> 2) + 4 * n + (i & 3); }

struct Unit { int pm, pn, e, aux; };

struct StaticOrder {
    int nM, nN, nwg, G, c;
    __host__ __device__ void init(int M, int N, int G_, int c_) { nM = M / BM; nN = N / BM; nwg = nM * nN; G = G_; c = c_; }
    __host__ __device__ bool next(int i, Unit& u) const {
        const long L = (long)i * G + c; if (L >= nwg) return false;
        int wgid = (int)L; { const int q = nwg / NXCD, r = nwg % NXCD, xcd = wgid % NXCD, off = wgid / NXCD; wgid = (xcd < r ? xcd * (q + 1) : r * (q + 1) + (xcd - r) * q) + off; }
        const int nig = WGM * nN, gid = wgid / nig, fm = gid * WGM, gsz = (nM - fm) < WGM ? (nM - fm) : WGM;
        u.pm = fm + ((wgid % nig) % gsz); u.pn = (wgid % nig) / gsz; u.e = 0; u.aux = 0; return true;
    }
};

__device__ __forceinline__ unsigned cvt_pk_bf16(float lo, float hi) { unsigned r; asm volatile("v_cvt_pk_bf16_f32 %0, %1, %2" : "=v"(r) : "v"(lo), "v"(hi)); return r; }

template <class Epi, class Src, bool TACC, bool GATHER, bool ALIGN_EPI, bool SP2>
__device__ __forceinline__ void gemm_phase(PG8_LAS unsigned char* lds, const int K, const Src& S, const Epi& E) {
    const int tid = threadIdx.x, wid = __builtin_amdgcn_readfirstlane(tid >> 6), lane = tid & 63, wr = wid >> 2, wc = wid & 3, fr = lane & 15, fq = lane >> 4;
    const int nt = K / BK;
    int Rr[2], Cc[2]; unsigned voffB[2];
#pragma unroll
    for (int i = 0; i < 2; ++i) { int R, C; stage_rc(tid * 16 + i * 8192, R, C); const int Rb = Epi::PERM ? ((R & ~31) + perm32(R & 31)) : R;
        Rr[i] = R; Cc[i] = C; voffB[i] = (unsigned)(Rb * K + C) * 2u; }
    const size_t kstep = (size_t)(BK * 2);
    const size_t hstep = (size_t)HALF * K * 2;
    const unsigned ldsw = (unsigned)wid * 1024u;
    const int aoff = lds_byte(wr * 64 + fr, fq * 8), boff = lds_byte(wc * 32 + fr, fq * 8);
#define PG8_SA(b, h) (((b) * 2 + (h)) * HTB)
#define PG8_SB(b, h) ((4 + (b) * 2 + (h)) * HTB)
#define PG8_STAGE(bufoff, gbase, voff) do { _Pragma("unroll") for (int _i = 0; _i < 2; ++_i) \
        __builtin_amdgcn_global_load_lds((const unsigned*)((const char*)(gbase) + (voff)[_i]), (PG8_LAS unsigned*)(lds + (bufoff) + ldsw + _i * 8192), 16, 0, 0); } while (0)
#define PG8_LDA(dst, b, h) do { _Pragma("unroll") for (int m = 0; m < 4; ++m) _Pragma("unroll") for (int k = 0; k < 2; ++k) dst[m][k] = *(const PG8_LAS bf16x8*)(lds + PG8_SA(b, h) + aoff + m * 2048 + k * 1024); } while (0)
#define PG8_LDB(dst, b, h) do { _Pragma("unroll") for (int n = 0; n < 2; ++n) _Pragma("unroll") for (int k = 0; k < 2; ++k) dst[n][k] = *(const PG8_LAS bf16x8*)(lds + PG8_SB(b, h) + boff + n * 2048 + k * 1024); } while (0)
#define PG8_MMA(ai, bj, At, Bt) do { __builtin_amdgcn_s_setprio(1); _Pragma("unroll") for (int m = 0; m < 4; ++m) _Pragma("unroll") for (int n = 0; n < 2; ++n) _Pragma("unroll") for (int k = 0; k < 2; ++k) \
        acc[ai][bj][m][n] = TACC ? __builtin_amdgcn_mfma_f32_16x16x32_bf16(Bt[n][k], At[m][k], acc[ai][bj][m][n], 0, 0, 0) \
                                 : __builtin_amdgcn_mfma_f32_16x16x32_bf16(At[m][k], Bt[n][k], acc[ai][bj][m][n], 0, 0, 0); __builtin_amdgcn_s_setprio(0); } while (0)
#define PG8_WAIT_V(n) asm volatile("s_waitcnt vmcnt(" #n ")" ::: "memory")
#define PG8_WAIT_L(n) asm volatile("s_waitcnt lgkmcnt(" #n ")" ::: "memory")
#define PG8_BAR __builtin_amdgcn_s_barrier()
#define PG8_SCHED __builtin_amdgcn_sched_barrier(0)
    Unit cur, nxt; int ui = 0;
    if (!S.next(0, cur)) return;
    f32x4 acc[2][2][4][2];
#pragma unroll
    for (int a = 0; a < 2; ++a)
#pragma unroll
        for (int b = 0; b < 2; ++b)
#pragma unroll
            for (int m = 0; m < 4; ++m)
#pragma unroll
                for (int n = 0; n < 2; ++n) acc[a][b][m][n] = (f32x4){0.f, 0.f, 0.f, 0.f};
    bf16x8 At[4][2], B0[2][2], B1[2][2];
    unsigned offA[2][2], nOffA[2][2];
    S.aoff(cur, K, Rr, Cc, offA);
    const char* cA = S.abase(cur); const char* cB = S.bbase(cur);
    if constexpr (SP2) {
        PG8_STAGE(PG8_SB(0, 0), cB, voffB); PG8_STAGE(PG8_SB(0, 1), cB + hstep, voffB); PG8_STAGE(PG8_SA(0, 0), cA, offA[0]); PG8_STAGE(PG8_SA(0, 1), cA, offA[1]);
        if (wr == 1) PG8_BAR;
        PG8_WAIT_V(2); PG8_BAR;
        PG8_STAGE(PG8_SB(1, 0), cB + kstep, voffB); PG8_STAGE(PG8_SA(1, 0), cA + kstep, offA[0]); PG8_STAGE(PG8_SB(1, 1), cB + hstep + kstep, voffB);
        PG8_WAIT_V(6); PG8_BAR;
    } else {
        PG8_STAGE(PG8_SB(0, 0), cB, voffB); PG8_STAGE(PG8_SA(0, 0), cA, offA[0]); PG8_STAGE(PG8_SB(0, 1), cB + hstep, voffB); PG8_STAGE(PG8_SA(0, 1), cA, offA[1]);
        if (wr == 1) PG8_BAR;
        PG8_WAIT_V(4); PG8_BAR;
        PG8_STAGE(PG8_SB(1, 0), cB + kstep, voffB); PG8_STAGE(PG8_SA(1, 0), cA + kstep, offA[0]); PG8_STAGE(PG8_SB(1, 1), cB + hstep + kstep, voffB);
        PG8_WAIT_V(6); PG8_BAR;
    }
    for (;;) {
        const bool has_next = S.next(ui + 1, nxt);
        const char* nA = has_next ? S.abase(nxt) : cA; const char* nB = has_next ? S.bbase(nxt) : cB;
        if constexpr (GATHER) {
            if (has_next) S.aoff(nxt, K, Rr, Cc, nOffA);
            else {
#pragma unroll
                for (int h = 0; h < 2; ++h)
#pragma unroll
                    for (int i = 0; i < 2; ++i) nOffA[h][i] = offA[h][i]; }
        }
#pragma nounroll
        for (int t = 0; t < nt; t += 2) {
            const bool last = (t == nt - 2);
            const char* a1 = cA + (size_t)(t + 1) * kstep;
            const char* a2 = last ? nA : cA + (size_t)(t + 2) * kstep; const char* b2 = last ? nB : cB + (size_t)(t + 2) * kstep;
            const char* a3 = a2 + kstep; const char* b3 = b2 + kstep;
            unsigned o2[2][2];
#pragma unroll
            for (int h = 0; h < 2; ++h)
#pragma unroll
                for (int i = 0; i < 2; ++i) o2[h][i] = (GATHER && last) ? nOffA[h][i] : offA[h][i];
            if constexpr (SP2) {
            PG8_LDB(B0, 0, 0); PG8_LDB(B1, 0, 1); PG8_SCHED; PG8_LDA(At, 0, 0); PG8_STAGE(PG8_SA(1, 1), a1, offA[1]);
            PG8_WAIT_V(8); PG8_WAIT_L(0); PG8_BAR; PG8_MMA(0, 0, At, B0); PG8_MMA(0, 1, At, B1); PG8_BAR; PG8_SCHED;
            PG8_LDA(At, 0, 1); PG8_STAGE(PG8_SB(0, 0), b2, voffB); PG8_STAGE(PG8_SB(0, 1), b2 + hstep, voffB); PG8_STAGE(PG8_SA(0, 0), a2, o2[0]);
            PG8_WAIT_V(8); PG8_WAIT_L(0); PG8_BAR; PG8_MMA(1, 0, At, B0); PG8_MMA(1, 1, At, B1); PG8_BAR; PG8_SCHED;
            PG8_LDB(B0, 1, 0); PG8_LDB(B1, 1, 1); PG8_SCHED; PG8_LDA(At, 1, 0); PG8_STAGE(PG8_SA(0, 1), a2, o2[1]);
            PG8_WAIT_V(8); PG8_WAIT_L(0); PG8_BAR; PG8_MMA(0, 0, At, B0); PG8_MMA(0, 1, At, B1); PG8_BAR; PG8_SCHED;
            PG8_LDA(At, 1, 1); PG8_STAGE(PG8_SB(1, 0), b3, voffB); PG8_STAGE(PG8_SB(1, 1), b3 + hstep, voffB); PG8_STAGE(PG8_SA(1, 0), a3, o2[0]);
            PG8_WAIT_V(8); PG8_WAIT_L(0); PG8_BAR; PG8_MMA(1, 0, At, B0); PG8_MMA(1, 1, At, B1); PG8_BAR; PG8_SCHED;
            } else {
            PG8_LDB(B0, 0, 0); PG8_SCHED; PG8_LDA(At, 0, 0); PG8_STAGE(PG8_SA(1, 1), a1, offA[1]);
            PG8_WAIT_L(8); PG8_BAR; PG8_WAIT_L(0); PG8_MMA(0, 0, At, B0); PG8_BAR; PG8_SCHED;
            PG8_LDB(B1, 0, 1); PG8_STAGE(PG8_SB(0, 0), b2, voffB);
            PG8_BAR; PG8_WAIT_L(0); PG8_MMA(0, 1, At, B1); PG8_BAR;
            PG8_LDA(At, 0, 1); PG8_STAGE(PG8_SA(0, 0), a2, o2[0]);
            PG8_BAR; PG8_WAIT_L(0); PG8_MMA(1, 0, At, B0); PG8_BAR; PG8_SCHED;
            PG8_STAGE(PG8_SB(0, 1), b2 + hstep, voffB);
            PG8_WAIT_V(6); PG8_BAR; PG8_MMA(1, 1, At, B1); PG8_BAR;
            PG8_LDB(B0, 1, 0); PG8_SCHED; PG8_LDA(At, 1, 0); PG8_STAGE(PG8_SA(0, 1), a2, o2[1]);
            PG8_WAIT_L(8); PG8_BAR; PG8_WAIT_L(0); PG8_MMA(0, 0, At, B0); PG8_BAR; PG8_SCHED;
            PG8_LDB(B1, 1, 1); PG8_STAGE(PG8_SB(1, 0), b3, voffB);
            PG8_BAR; PG8_WAIT_L(0); PG8_MMA(0, 1, At, B1); PG8_BAR;
            PG8_LDA(At, 1, 1); PG8_STAGE(PG8_SA(1, 0), a3, o2[0]);
            PG8_BAR; PG8_WAIT_L(0); PG8_MMA(1, 0, At, B0); PG8_BAR; PG8_SCHED;
            PG8_STAGE(PG8_SB(1, 1), b3 + hstep, voffB);
            PG8_WAIT_V(6); PG8_BAR; PG8_MMA(1, 1, At, B1); PG8_BAR;
            }
        }
        if constexpr (ALIGN_EPI) { if (wr == 0) PG8_BAR; }
        E(acc, cur, wr, wc, fr, fq);
        if (!has_next) break;
#pragma unroll
        for (int a = 0; a < 2; ++a)
#pragma unroll
            for (int b = 0; b < 2; ++b)
#pragma unroll
                for (int m = 0; m < 4; ++m)
#pragma unroll
                    for (int n = 0; n < 2; ++n) acc[a][b][m][n] = (f32x4){0.f, 0.f, 0.f, 0.f};
        cur = nxt; cA = nA; cB = nB; ++ui;
        if constexpr (GATHER) {
#pragma unroll
            for (int h = 0; h < 2; ++h)
#pragma unroll
                for (int i = 0; i < 2; ++i) offA[h][i] = nOffA[h][i]; }
        if constexpr (ALIGN_EPI) { if (wr == 1) PG8_BAR; }
    }
    PG8_WAIT_V(0);
    if constexpr (!ALIGN_EPI) { if (wr == 0) PG8_BAR; }
    PG8_BAR;
#undef PG8_SA
#undef PG8_SB
#undef PG8_STAGE
#undef PG8_LDA
#undef PG8_LDB
#undef PG8_MMA
#undef PG8_WAIT_V
#undef PG8_WAIT_L
#undef PG8_BAR
#undef PG8_SCHED
}
}
constexpr int NB = 16, SEQ = 2048, DM = 1024, M = NB * SEQ, PLE = 256;
constexpr int HYW = 512, NAW = 512, NH = 8, HD = 64, UTR = 2048;
constexpr int NE = 32, DE = 512, LCAP = M;
constexpr int GSTR = 4104;
constexpr float EPS = 1e-6f;
constexpr int NWAVES = 8;

constexpr size_t MiB = 1u << 20, KiB = 1u << 10;
constexpr size_t WS_CTL = 0, CTL_ZERO_BYTES = 1 * MiB;
constexpr size_t WS_RSX = 1 * MiB, WS_RS1 = WS_RSX + 128 * KiB, WS_RS2 = WS_RS1 + 128 * KiB;
constexpr size_t WS_WR = 1 * MiB + 512 * KiB;
constexpr size_t WS_GATE = 2 * MiB;
constexpr size_t WS_LIST = 4 * MiB;
constexpr size_t WS_WIN = 8 * MiB, WS_WOUT = 14 * MiB, WS_WG = 16 * MiB, WS_WP = 18 * MiB;
constexpr size_t WS_HYK = 20 * MiB;
constexpr size_t WS_W13 = 30 * MiB, WS_W2 = 94 * MiB;
constexpr size_t WS_PB = 126 * MiB;
constexpr size_t WS_A1 = 142 * MiB;
constexpr size_t WS_A2 = 206 * MiB;
constexpr size_t WS_A3 = 334 * MiB;
constexpr size_t WS_A4 = 414 * MiB;
constexpr size_t WS_END = 478 * MiB;
constexpr size_t WS_XB = WS_A1, WS_MIX = WS_A1, WS_YK0 = WS_A1, WS_H3 = WS_A1;
constexpr size_t WS_UT = WS_A2, WS_H1 = WS_A2, WS_H2 = WS_A2 + 64 * MiB;
constexpr size_t WS_Q = WS_A3, WS_K = WS_A3 + 32 * MiB, WS_HID = WS_A3, WS_PL = WS_A3;
constexpr size_t WS_YT = WS_A4, WS_YNA = WS_A4 + 32 * MiB, WS_YK1 = WS_A4;
static_assert(WS_HYK + (size_t)1024 * GSTR * 2 <= WS_W13 && WS_A3 + (size_t)(2 * M + NE * 256) * DE * 2 <= WS_A4, "d_ws map");
constexpr int CW_TMO = 0, CW_CODE = 1;
constexpr int CW_BAR = 4096;
constexpr int CW_CNT = 8192;
constexpr int RING_OFF = 0, RING_BYTES = 131072;
constexpr int LDSCTL_OFF = RING_BYTES, TAB_OFF = LDSCTL_OFF, MISC_OFF = LDSCTL_OFF + 320;
constexpr int LDS_BYTES = 147456;

#define GAS __attribute__((address_space(1)))
#define LAS __attribute__((address_space(3)))
typedef unsigned short bf16;
typedef unsigned v4u __attribute__((ext_vector_type(4)));
typedef unsigned v2u __attribute__((ext_vector_type(2)));
typedef float f32x4 __attribute__((ext_vector_type(4)));
typedef short bf16x8 __attribute__((ext_vector_type(8)));
typedef GAS unsigned gu32;
#define RLX_AGENT __ATOMIC_RELAXED, __HIP_MEMORY_SCOPE_AGENT
#define LDS_WAIT() asm volatile("s_waitcnt lgkmcnt(0)" ::: "memory")
#define VM_WAIT() asm volatile("s_waitcnt vmcnt(0)" ::: "memory")
__device__ __forceinline__ unsigned f2bf(float f) { unsigned u = __builtin_bit_cast(unsigned, f); return (u + 0x7fffu + ((u >> 16) & 1u)) >> 16; }
__device__ __forceinline__ unsigned pk2(float lo, float hi) { return f2bf(lo) | (f2bf(hi) << 16); }
__device__ __forceinline__ float bf2f(unsigned b) { return __builtin_bit_cast(float, b << 16); }
__device__ __forceinline__ float bflo(unsigned w) { return __builtin_bit_cast(float, w << 16); }
__device__ __forceinline__ float bfhi(unsigned w) { return __builtin_bit_cast(float, w & 0xffff0000u); }
__device__ __forceinline__ float bfr(float f) { return bf2f(f2bf(f)); }
__device__ __forceinline__ float wave_sum(float v) {
#pragma unroll
    for (int o = 1; o < 64; o <<= 1) v += __shfl_xor(v, o);
    return v;
}

#define XB_TMO      128
#define XB_XCNT(j)  (256  + 64 * (j))
#define XB_XSUB(j)  (1280 + 64 * (j))
#define XB_XGEN(j)  (2304 + 64 * (j))
#define XB_TOP      3328
#define XB_TOPGEN   3392
#define XCD_BAR_WORDS 3456
#define XB_SPIN_CAP (1u << 18)

__device__ __forceinline__ unsigned xb_ld(unsigned* p)              { return __hip_atomic_load(p, __ATOMIC_RELAXED, __HIP_MEMORY_SCOPE_AGENT); }
__device__ __forceinline__ unsigned xb_add(unsigned* p, unsigned v) { return __hip_atomic_fetch_add(p, v, __ATOMIC_RELAXED, __HIP_MEMORY_SCOPE_AGENT); }
__device__ __forceinline__ unsigned xb_xcc_id() { return (unsigned)__builtin_amdgcn_s_getreg((3 << 11) | 20) & 0xFu; }
#define XB_SPIN(cond, bar) do { unsigned _sp = 0; while (cond) { __builtin_amdgcn_s_sleep(1); \
    if ((++_sp & 255u) == 0u) { if (xb_ld(&(bar)[XB_TMO])) break; if (_sp > XB_SPIN_CAP) { atomicAdd(&(bar)[XB_TMO], 1u); break; } } } } while (0)

struct XcdBarrier {
    unsigned* bar; unsigned x;
    volatile LAS unsigned* st;
};

__device__ __forceinline__ XcdBarrier xcd_barrier_post(unsigned* bar, volatile LAS unsigned* st) {
    XcdBarrier b; b.bar = bar; b.x = xb_xcc_id(); b.st = st;
    if (threadIdx.x == 0) (void)xb_add(&bar[XB_XCNT(b.x)], 1u);
    return b;
}
__device__ __forceinline__ void xcd_barrier_complete(unsigned* bar, unsigned x, unsigned& nloc, unsigned& nx) {
    const unsigned G = gridDim.x * gridDim.y * gridDim.z;
    unsigned sum, cnt, mine, sp = 0u;
    for (;;) {
        sum = 0u; cnt = 0u; mine = 0u;
#pragma unroll
        for (unsigned j = 0; j < 16; ++j) { const unsigned c = xb_ld(&bar[XB_XCNT(j)]); sum += c; cnt += (c > 0u) ? 1u : 0u; mine = (j == x) ? c : mine; }
        if (sum == G) break;
        __builtin_amdgcn_s_sleep(1);
        if ((++sp & 255u) == 0u) { if (xb_ld(&bar[XB_TMO])) break; if (sp > XB_SPIN_CAP) { atomicAdd(&bar[XB_TMO], 1u); break; } }
    }
    nloc = mine > 0u ? mine : 1u; nx = cnt > 0u ? cnt : 1u;
}

__device__ __forceinline__ void xcd_barrier(const XcdBarrier& b) {
    asm volatile("s_waitcnt vmcnt(0)" ::: "memory");
    __syncthreads();
    if (threadIdx.x == 0) {
        unsigned* bar = b.bar;
        __builtin_amdgcn_s_waitcnt(0);
        unsigned nloc = b.st[0], nx = b.st[1];
        if (nloc == 0u) { xcd_barrier_complete(bar, b.x, nloc, nx); b.st[0] = nloc; b.st[1] = nx; }
        const unsigned old = xb_add(&bar[XB_XSUB(b.x)], 1u);
        const unsigned gen = old / nloc;
        if (old + 1u == (gen + 1u) * nloc) {
            __builtin_amdgcn_fence(__ATOMIC_RELEASE, "agent");
            asm volatile("s_waitcnt vmcnt(0)" ::: "memory");
            const unsigned og = xb_add(&bar[XB_TOP], 1u);
            const unsigned tg = og / nx;
            if (og + 1u == (tg + 1u) * nx) xb_add(&bar[XB_TOPGEN], 1u);
            else XB_SPIN(xb_ld(&bar[XB_TOPGEN]) == tg, bar);
            __builtin_amdgcn_fence(__ATOMIC_ACQUIRE, "agent");
            xb_add(&bar[XB_XGEN(b.x)], 1u);
            asm volatile("s_waitcnt vmcnt(0)" ::: "memory");
        } else {
            XB_SPIN(xb_ld(&bar[XB_XGEN(b.x)]) == gen, bar);
            __builtin_amdgcn_fence(__ATOMIC_ACQUIRE, "agent");
            asm volatile("s_waitcnt vmcnt(0)" ::: "memory");
        }
    }
    __syncthreads();
}
struct Frame {
    LAS unsigned char* lds;
    volatile LAS unsigned* MISC;
    gu32* ctl;
    int tid, lane, wave;
    int vcu, G;
    const float* const* in; float* out; unsigned char* ws;
};
#define WSP(T, off) ((T*)(F.ws + (off)))

struct DenseSrc : pg8::StaticOrder {
    const char* A; const char* B; size_t tstepA, tstepB;
    __device__ __forceinline__ void set(const void* A_, const void* B_, int M_, int N_, int K_, int G_, int c_) { init(M_, N_, G_, c_); A = (const char*)A_; B = (const char*)B_; tstepA = (size_t)256 * K_ * 2; tstepB = (size_t)256 * K_ * 2; }
    __device__ __forceinline__ const char* abase(const pg8::Unit& u) const { return A + (size_t)u.pm * tstepA; }
    __device__ __forceinline__ const char* bbase(const pg8::Unit& u) const { return B + (size_t)u.pn * tstepB; }
    __device__ __forceinline__ void aoff(const pg8::Unit&, int K, const int (&R)[2], const int (&C)[2], unsigned (&off)[2][2]) const {
#pragma unroll
        for (int h = 0; h < 2; ++h)
#pragma unroll
            for (int i = 0; i < 2; ++i) off[h][i] = (unsigned)((128 * h + R[i]) * K + C[i]) * 2u;
    }
};

using pg8::f32x4; using pg8::Unit;
struct EpiUT {
    static constexpr bool PERM = false;
    bf16* UT; const float* rstd;
    __device__ __forceinline__ void operator()(const f32x4 (&acc)[2][2][4][2], const Unit& u, int wr, int wc, int fr, int fq) const {
#pragma unroll
        for (int ai = 0; ai < 2; ++ai)
#pragma unroll
            for (int m = 0; m < 4; ++m) {
                const int tok0 = u.pm * 256 + ai * 128 + wr * 64 + m * 16 + 4 * fq;
                const f32x4 rs = *(const f32x4*)(rstd + tok0);
#pragma unroll
                for (int bj = 0; bj < 2; ++bj)
#pragma unroll
                    for (int n = 0; n < 2; ++n) {
                        const int col = u.pn * 256 + bj * 128 + wc * 32 + n * 16 + fr;
                        const f32x4 v = acc[ai][bj][m][n] * rs;
                        v2u w; w.x = pg8::cvt_pk_bf16(v[0], v[1]); w.y = pg8::cvt_pk_bf16(v[2], v[3]);
                        *(v2u*)(UT + (size_t)col * M + tok0) = w; }
            }
    }
};
struct EpiQK {
    static constexpr bool PERM = true;
    bf16* Q; bf16* Kp; const float* rstd;
    __device__ __forceinline__ void operator()(const f32x4 (&acc)[2][2][4][2], const Unit& u, int wr, int wc, int fr, int fq) const {
        const int row0 = u.pm * 256 + wr * 64 + fr; const int t = u.pn >> 1; bf16* base = t ? Kp : Q; const float sc = t ? 1.f : 0.125f;
        const int col0 = (u.pn & 1) * 256 + wc * 32 + 8 * fq;
#pragma unroll
        for (int ai = 0; ai < 2; ++ai)
#pragma unroll
            for (int m = 0; m < 4; ++m) { const int row = row0 + ai * 128 + m * 16; const float r = rstd[row] * sc; bf16* rowp = base + (size_t)row * 512 + col0;
#pragma unroll
                for (int bj = 0; bj < 2; ++bj) { const f32x4 v0 = acc[ai][bj][m][0] * r, v1 = acc[ai][bj][m][1] * r;
                    v4u w; w.x = pg8::cvt_pk_bf16(v0[0], v0[1]); w.y = pg8::cvt_pk_bf16(v0[2], v0[3]); w.z = pg8::cvt_pk_bf16(v1[0], v1[1]); w.w = pg8::cvt_pk_bf16(v1[2], v1[3]);
                    *(v4u*)(rowp + bj * 128) = w; } }
    }
};
struct EpiH1 {
    static constexpr bool PERM = true;
    bf16* H1; const float* x;
    __device__ __forceinline__ void operator()(const f32x4 (&acc)[2][2][4][2], const Unit& u, int wr, int wc, int fr, int fq) const {
        const int row0 = u.pm * 256 + wr * 64 + fr; const int col0 = u.pn * 256 + wc * 32 + 8 * fq;
#pragma unroll
        for (int ai = 0; ai < 2; ++ai)
#pragma unroll
            for (int m = 0; m < 4; ++m) { const size_t ro = (size_t)(row0 + ai * 128 + m * 16) * DM + col0;
#pragma unroll
                for (int bj = 0; bj < 2; ++bj) { const f32x4 x0 = *(const f32x4*)(x + ro + bj * 128), x1 = *(const f32x4*)(x + ro + bj * 128 + 4);
                    const f32x4 v0 = acc[ai][bj][m][0] + x0, v1 = acc[ai][bj][m][1] + x1;
                    v4u w; w.x = pg8::cvt_pk_bf16(v0[0], v0[1]); w.y = pg8::cvt_pk_bf16(v0[2], v0[3]); w.z = pg8::cvt_pk_bf16(v1[0], v1[1]); w.w = pg8::cvt_pk_bf16(v1[2], v1[3]);
                    *(v4u*)(H1 + ro + bj * 128) = w; } }
    }
};
struct EpiPL {
    static constexpr bool PERM = true;
    bf16* PL;
    __device__ __forceinline__ void operator()(const f32x4 (&acc)[2][2][4][2], const Unit& u, int wr, int wc, int fr, int fq) const {
        const int row0 = u.pm * 256 + wr * 64 + fr; const int col0 = u.pn * 256 + wc * 32 + 8 * fq;
#pragma unroll
        for (int ai = 0; ai < 2; ++ai)
#pragma unroll
            for (int m = 0; m < 4; ++m) { const size_t ro = (size_t)(row0 + ai * 128 + m * 16) * DM + col0;
#pragma unroll
                for (int bj = 0; bj < 2; ++bj) { const f32x4 v0 = acc[ai][bj][m][0], v1 = acc[ai][bj][m][1];
                    v4u w; w.x = pg8::cvt_pk_bf16(v0[0], v0[1]); w.y = pg8::cvt_pk_bf16(v0[2], v0[3]); w.z = pg8::cvt_pk_bf16(v1[0], v1[1]); w.w = pg8::cvt_pk_bf16(v1[2], v1[3]);
                    *(v4u*)(PL + ro + bj * 128) = w; } }
    }
};
__device__ __forceinline__ float sigmoidf_(float v) { return 1.f / (1.f + __expf(-v)); }
struct EpiPLE {
    static constexpr bool PERM = true;
    bf16* H3; const bf16* H2; const bf16* PL; const float* rstd;
    __device__ __forceinline__ void operator()(const f32x4 (&acc)[2][2][4][2], const Unit& u, int wr, int wc, int fr, int fq) const {
        const int row0 = u.pm * 256 + wr * 64 + fr; const int col0 = u.pn * 256 + wc * 32 + 8 * fq;
#pragma unroll
        for (int ai = 0; ai < 2; ++ai)
#pragma unroll
            for (int m = 0; m < 4; ++m) { const int row = row0 + ai * 128 + m * 16; const size_t ro = (size_t)row * DM + col0; const float r = rstd[row];
#pragma unroll
                for (int bj = 0; bj < 2; ++bj) { const v4u h = *(const v4u*)(H2 + ro + bj * 128), p = *(const v4u*)(PL + ro + bj * 128);
                    const f32x4 a0 = acc[ai][bj][m][0] * r, a1 = acc[ai][bj][m][1] * r;
                    float o[8];
                    o[0] = bflo(h.x) + bflo(p.x) * sigmoidf_(a0[0]); o[1] = bfhi(h.x) + bfhi(p.x) * sigmoidf_(a0[1]);
                    o[2] = bflo(h.y) + bflo(p.y) * sigmoidf_(a0[2]); o[3] = bfhi(h.y) + bfhi(p.y) * sigmoidf_(a0[3]);
                    o[4] = bflo(h.z) + bflo(p.z) * sigmoidf_(a1[0]); o[5] = bfhi(h.z) + bfhi(p.z) * sigmoidf_(a1[1]);
                    o[6] = bflo(h.w) + bflo(p.w) * sigmoidf_(a1[2]); o[7] = bfhi(h.w) + bfhi(p.w) * sigmoidf_(a1[3]);
                    v4u w; w.x = pg8::cvt_pk_bf16(o[0], o[1]); w.y = pg8::cvt_pk_bf16(o[2], o[3]); w.z = pg8::cvt_pk_bf16(o[4], o[5]); w.w = pg8::cvt_pk_bf16(o[6], o[7]);
                    *(v4u*)(H3 + ro + bj * 128) = w; } }
    }
};

template <class GainF, class RowF>
__device__ __forceinline__ void p0_transpose_item(const float* W, int N, bf16* WT, int ldk, LAS float* scr, int item, int lane, GainF gain, RowF rowmap) {
    const int nblk = N / 32, kb = item / nblk, nb = item % nblk, k0 = 64 * kb, n0 = 32 * nb;
#pragma unroll 8
    for (int i = 0; i < 32; ++i) { const int kk = 2 * i + (lane >> 5); scr[kk * 33 + (lane & 31)] = W[(size_t)(k0 + kk) * N + n0 + (lane & 31)] * gain(k0 + kk); }
    LDS_WAIT(); asm volatile("" ::: "memory");
    const int c = lane & 7;
#pragma unroll
    for (int j = 0; j < 4; ++j) { const int n = (lane >> 3) + 8 * j; const LAS float* s = scr + (8 * c) * 33 + n;
        v4u o; o.x = pk2(s[0 * 33], s[1 * 33]); o.y = pk2(s[2 * 33], s[3 * 33]); o.z = pk2(s[4 * 33], s[5 * 33]); o.w = pk2(s[6 * 33], s[7 * 33]);
        *(GAS v4u*)(WT + (size_t)rowmap(n0 + n) * ldk + k0 + 8 * c) = o; }
    LDS_WAIT(); asm volatile("" ::: "memory");
}
__device__ __forceinline__ void p0_filter_task(Frame& F, int task) {
    const int lane = F.lane, n0 = task * 4;
    const float* w1 = F.in[6]; const float* b1 = F.in[7]; const float* f1 = F.in[8]; const float* w2 = F.in[9]; const float* b2 = F.in[10]; const float* f2 = F.in[11]; const float* w3 = F.in[12];
    bf16* HYK = WSP(bf16, WS_HYK);
    float h2[4];
#pragma unroll
    for (int p = 0; p < 4; ++p) {
        const int n = n0 + p; const float t = (float)n * (1.0f / 2047.0f); const float w = 6.283185307179586f * (float)n * (1.0f / 2048.0f);
        float z = 0.f;
        if (lane == 0) z = t;
        else if (lane <= 16) { const float band = 1e-4f + (float)(lane - 1) * ((15.0f - 1e-4f) / 15.0f); z = cosf(band * w); }
        else if (lane <= 32) { const float band = 1e-4f + (float)(lane - 17) * ((15.0f - 1e-4f) / 15.0f); z = -sinf(band * w); }
        float a = b1[lane];
#pragma unroll
        for (int i = 0; i < 33; ++i) a += __shfl(z, i) * w1[i * 64 + lane];
        const float h1 = sinf(f1[lane] * a);
        float a2 = b2[lane];
#pragma unroll 16
        for (int j = 0; j < 64; ++j) a2 += __shfl(h1, j) * w2[j * 64 + lane];
        h2[p] = sinf(f2[lane] * a2);
    }
#pragma nounroll
    for (int qt = 0; qt < 4; ++qt) {
        float acc[8][4];
#pragma unroll
        for (int i = 0; i < 8; ++i)
#pragma unroll
            for (int p = 0; p < 4; ++p) acc[i][p] = 0.f;
#pragma nounroll
        for (int j = 0; j < 64; ++j) {
            float hj[4];
#pragma unroll
            for (int p = 0; p < 4; ++p) hj[p] = __shfl(h2[p], j);
#pragma unroll
            for (int i = 0; i < 8; ++i) { const float wv = w3[(size_t)j * 2048 + (qt * 8 + i) * 64 + lane];
#pragma unroll
                for (int p = 0; p < 4; ++p) acc[i][p] += hj[p] * wv; }
        }
#pragma unroll
        for (int i = 0; i < 8; ++i) {
            const int col = (qt * 8 + i) * 64 + lane, dir = col >> 10, o = (col >> 9) & 1, c = col & 511;
            const float dl = 3.0701134573253944f + (float)c * ((15.350567286626972f - 3.0701134573253944f) / 511.0f);
#pragma unroll
            for (int p = 0; p < 4; ++p) { const int n = n0 + p; const float t = (float)n * (1.0f / 2047.0f);
                const float val = acc[i][p] * expf(-t * dl);
                const int q = dir ? 2048 + n : 2048 - n;
                if (!(dir == 1 && n == 0)) HYK[(size_t)(o * 512 + c) * GSTR + q] = (bf16)f2bf(val); }
        }
    }
}
__device__ __forceinline__ void p0_prologue(Frame& F) {
    LAS float* scr = (LAS float*)(F.lds + RING_OFF + F.wave * 16384);
    const int gw = F.vcu * NWAVES + F.wave, NGW = F.G * NWAVES, lane = F.lane;
    for (int task = gw; task < 512; task += NGW) p0_filter_task(F, task);
    { bf16* HYK = WSP(bf16, WS_HYK);
      for (int i = blockIdx.x * 512 + F.tid; i < 1024 * 9; i += F.G * 512) { const int row = i / 9, j = i % 9; HYK[(size_t)row * GSTR + (j == 0 ? 0 : 4095 + j)] = 0; } }
    {
        const float* g_mix = F.in[2]; const float* g_ohy = F.in[15]; const float* g_ona = F.in[16]; const float* g_ffn = F.in[18]; const float* g_ple = F.in[26];
        constexpr int I_IN = 16 * 96, I_OUT = 16 * 32, I_G = 16 * 32, I_P = 4 * 32, I_E1 = 16 * 16, I_E2 = 8 * 32;
        constexpr int NITEMS = I_IN + I_OUT + I_G + I_P + NE * (2 * I_E1 + I_E2);
        for (int it = gw; it < NITEMS; it += NGW) {
            int r = it;
            if (r < I_IN) { p0_transpose_item(F.in[3], 3072, WSP(bf16, WS_WIN), DM, scr, r, lane, [&](int k) { return g_mix[k]; },
                                              [](int n) { return n < 1536 ? n : (n < 2560 ? n + 512 : n - 1024); }); continue; } r -= I_IN;
            if (r < I_OUT) { p0_transpose_item(F.in[17], 1024, WSP(bf16, WS_WOUT), DM, scr, r, lane, [&](int k) { return k < 512 ? g_ohy[k] : g_ona[k - 512]; }, [](int n) { return n; }); continue; } r -= I_OUT;
            if (r < I_G) { p0_transpose_item(F.in[27], 1024, WSP(bf16, WS_WG), DM, scr, r, lane, [&](int k) { return g_ple[k]; }, [](int n) { return n; }); continue; } r -= I_G;
            if (r < I_P) { p0_transpose_item(F.in[28], 1024, WSP(bf16, WS_WP), PLE, scr, r, lane, [](int) { return 1.0f; }, [](int n) { return n; }); continue; } r -= I_P;
            const int e = r / (2 * I_E1 + I_E2); r -= e * (2 * I_E1 + I_E2);
            if (r < I_E1) { p0_transpose_item(F.in[23] + (size_t)e * DM * DE, DE, WSP(bf16, WS_W13) + (size_t)e * 1024 * DM, DM, scr, r, lane, [&](int k) { return g_ffn[k]; }, [](int n) { return (n >> 2) * 8 + (n & 3); }); continue; } r -= I_E1;
            if (r < I_E1) { p0_transpose_item(F.in[24] + (size_t)e * DM * DE, DE, WSP(bf16, WS_W13) + (size_t)e * 1024 * DM, DM, scr, r, lane, [&](int k) { return g_ffn[k]; }, [](int n) { return (n >> 2) * 8 + (n & 3) + 4; }); continue; } r -= I_E1;
            p0_transpose_item(F.in[25] + (size_t)e * DE * DM, DM, WSP(bf16, WS_W2) + (size_t)e * DM * DE, DE, scr, r, lane, [](int) { return 1.0f; }, [](int n) { return n; });
        }
        float* WR = WSP(float, WS_WR);
        for (int i = blockIdx.x * 512 + F.tid; i < 36 * 1024; i += F.G * 512) { const int j = i >> 10, k = i & 1023;
            WR[i] = (j < 4 ? F.in[19][k * 4 + j] : F.in[21][k * 32 + (j - 4)]) * g_ffn[k]; }
    }
    {
        const float* x = F.in[0]; bf16* XB = WSP(bf16, WS_XB); float* rsx = WSP(float, WS_RSX);
        for (int m = gw; m < M; m += NGW) {
            const GAS f32x4* xr = (const GAS f32x4*)(x + (size_t)m * DM) + lane;
            f32x4 v[4]; float s = 0.f;
#pragma unroll
            for (int j = 0; j < 4; ++j) { v[j] = xr[64 * j]; s += (v[j].x * v[j].x + v[j].y * v[j].y) + (v[j].z * v[j].z + v[j].w * v[j].w); }
            s = wave_sum(s);
            if (lane == 0) rsx[m] = rsqrtf(s * (1.0f / DM) + EPS);
            GAS v2u* o8 = (GAS v2u*)(XB + (size_t)m * DM) + lane;
#pragma unroll
            for (int j = 0; j < 4; ++j) { v2u w; w.x = pk2(v[j].x, v[j].y); w.y = pk2(v[j].z, v[j].w); o8[64 * j] = w; }
        }
        const float* p = F.in[1]; bf16* PB = WSP(bf16, WS_PB);
        for (int m = gw; m < M; m += NGW) {
            const f32x4 v = ((const GAS f32x4*)(p + (size_t)m * PLE))[lane];
            v2u w; w.x = pk2(v.x, v.y); w.y = pk2(v.z, v.w); ((GAS v2u*)(PB + (size_t)m * PLE))[lane] = w;
        }
    }
}

__device__ __forceinline__ float sc3(const bf16* u, int s, float w0, float w1, float w2, float cb) {
    const float um = s > 0 ? bf2f(u[s - 1]) : 0.f, u0 = bf2f(u[s]), up = s < SEQ - 1 ? bf2f(u[s + 1]) : 0.f;
    return cb + w0 * um + w1 * u0 + w2 * up;
}
__device__ __forceinline__ void hyena_naive(Frame& F) {
    LAS float* Gl = (LAS float*)F.lds; LAS float* z = Gl + 4112;
    const bf16* UT = WSP(bf16, WS_UT); const bf16* HYK = WSP(bf16, WS_HYK); bf16* YT = WSP(bf16, WS_YT);
    const float* cw = F.in[4]; const float* cbv = F.in[5]; const float* skip = F.in[13];
    const int tid = F.tid;
    for (int unit = blockIdx.x; unit < HYW * NB; unit += F.G) {
        const int c = unit / NB, b = unit % NB;
        const bf16* ux1 = UT + (size_t)c * M + b * SEQ; const bf16* ux2 = UT + (size_t)(512 + c) * M + b * SEQ; const bf16* uv = UT + (size_t)(1024 + c) * M + b * SEQ;
        __syncthreads();
        for (int s = tid; s < SEQ; s += 512) z[s] = bfr(sc3(uv, s, cw[1024 + c], cw[1536 + 1024 + c], cw[3072 + 1024 + c], cbv[1024 + c]));
        for (int o = 0; o < 2; ++o) {
            for (int q = tid; q < GSTR; q += 512) Gl[q] = bf2f(HYK[(size_t)(o * 512 + c) * GSTR + q]);
            __syncthreads();
            const int t4 = tid * 4; float acc[4] = {0.f, 0.f, 0.f, 0.f};
            for (int s = 0; s < SEQ; ++s) { const float zs = z[s];
#pragma unroll
                for (int j = 0; j < 4; ++j) acc[j] += Gl[2048 - (t4 + j) + s] * zs; }
            const bf16* ug = o ? ux2 : ux1; const int gc = o ? 512 + c : c; const float sk = skip[o * 512 + c];
            float outv[4];
#pragma unroll
            for (int j = 0; j < 4; ++j) { const float g = sc3(ug, t4 + j, cw[gc], cw[1536 + gc], cw[3072 + gc], cbv[gc]); outv[j] = g * (acc[j] + z[t4 + j] * sk); }
            __syncthreads();
            if (o == 0) {
#pragma unroll
                for (int j = 0; j < 4; ++j) z[t4 + j] = bfr(outv[j]);
            } else {
                v2u w; w.x = pk2(outv[0], outv[1]); w.y = pk2(outv[2], outv[3]); *(v2u*)(YT + (size_t)c * M + b * SEQ + t4) = w;
            }
            __syncthreads();
        }
    }
}
__device__ __forceinline__ void natten_naive(Frame& F) {
    const bf16* Q = WSP(bf16, WS_Q); const bf16* Kb = WSP(bf16, WS_K); const bf16* VT = WSP(bf16, WS_UT) + (size_t)1536 * M; bf16* YNA = WSP(bf16, WS_YNA);
    const float* rpb = F.in[14];
    for (int unit = blockIdx.x; unit < M / 64; unit += F.G) {
        const int b = unit >> 5, r = unit & 31, h = F.tid >> 6, qc = F.tid & 63;
        const int tok = b * SEQ + r * 64 + qc;
        float q[64], o[64];
#pragma unroll
        for (int d8 = 0; d8 < 8; ++d8) { const v4u w = *(const v4u*)(Q + (size_t)tok * 512 + h * 64 + d8 * 8);
            q[d8 * 8 + 0] = bflo(w.x); q[d8 * 8 + 1] = bfhi(w.x); q[d8 * 8 + 2] = bflo(w.y); q[d8 * 8 + 3] = bfhi(w.y); q[d8 * 8 + 4] = bflo(w.z); q[d8 * 8 + 5] = bfhi(w.z); q[d8 * 8 + 6] = bflo(w.w); q[d8 * 8 + 7] = bfhi(w.w); }
#pragma unroll
        for (int d = 0; d < 64; ++d) o[d] = 0.f;
        const int rs0 = min(max(r - 4, 0), 24), cs0 = min(max(qc - 8, 0), 48);
        float mx = -1e30f, l = 0.f;
        for (int kk = 0; kk < 128; ++kk) {
            const int krow = rs0 + (kk >> 4), kcol = cs0 + (kk & 15), kt = b * SEQ + krow * 64 + kcol;
            float s = 0.f;
#pragma unroll
            for (int d8 = 0; d8 < 8; ++d8) { const v4u w = *(const v4u*)(Kb + (size_t)kt * 512 + h * 64 + d8 * 8);
                s += q[d8 * 8 + 0] * bflo(w.x) + q[d8 * 8 + 1] * bfhi(w.x) + q[d8 * 8 + 2] * bflo(w.y) + q[d8 * 8 + 3] * bfhi(w.y) + q[d8 * 8 + 4] * bflo(w.z) + q[d8 * 8 + 5] * bfhi(w.z) + q[d8 * 8 + 6] * bflo(w.w) + q[d8 * 8 + 7] * bfhi(w.w); }
            s += rpb[(h * 15 + (krow - r + 7)) * 31 + (kcol - qc + 15)];
            const float mn = fmaxf(mx, s), scl = __expf(mx - mn), p = __expf(s - mn);
            l = l * scl + p; mx = mn;
#pragma unroll
            for (int d = 0; d < 64; ++d) o[d] = o[d] * scl + p * bf2f(VT[(size_t)(h * 64 + d) * M + kt]);
        }
        const float inv = 1.f / l;
#pragma unroll
        for (int d8 = 0; d8 < 8; ++d8) { v4u w; w.x = pk2(o[d8 * 8] * inv, o[d8 * 8 + 1] * inv); w.y = pk2(o[d8 * 8 + 2] * inv, o[d8 * 8 + 3] * inv); w.z = pk2(o[d8 * 8 + 4] * inv, o[d8 * 8 + 5] * inv); w.w = pk2(o[d8 * 8 + 6] * inv, o[d8 * 8 + 7] * inv);
            *(v4u*)(YNA + (size_t)tok * 512 + h * 64 + d8 * 8) = w; }
    }
}

__device__ __forceinline__ void mixnorm(Frame& F) {
    LAS bf16* T = (LAS bf16*)F.lds; constexpr int TP = 520;
    const bf16* YT = WSP(bf16, WS_YT); const bf16* YNA = WSP(bf16, WS_YNA); bf16* MIX = WSP(bf16, WS_MIX);
    const int tid = F.tid, lane = F.lane, wave = F.wave;
    for (int unit = blockIdx.x; unit < M / 64; unit += F.G) {
        const int tok0 = unit * 64;
        __syncthreads();
#pragma unroll
        for (int it = 0; it < 8; ++it) { const int idx = it * 512 + tid, c = idx >> 3, tg = idx & 7;
            const v4u w = *(const v4u*)(YT + (size_t)c * M + tok0 + tg * 8);
            LAS bf16* d = T + (tg * 8) * TP + c;
            d[0 * TP] = (bf16)(w.x & 0xffff); d[1 * TP] = (bf16)(w.x >> 16); d[2 * TP] = (bf16)(w.y & 0xffff); d[3 * TP] = (bf16)(w.y >> 16);
            d[4 * TP] = (bf16)(w.z & 0xffff); d[5 * TP] = (bf16)(w.z >> 16); d[6 * TP] = (bf16)(w.w & 0xffff); d[7 * TP] = (bf16)(w.w >> 16); }
        __syncthreads();
#pragma unroll
        for (int i = 0; i < 8; ++i) { const int tl = wave * 8 + i, tok = tok0 + tl;
            {   const v4u w = *(const LAS v4u*)(T + tl * TP + lane * 8);
                float v[8] = {bflo(w.x), bfhi(w.x), bflo(w.y), bfhi(w.y), bflo(w.z), bfhi(w.z), bflo(w.w), bfhi(w.w)}; float s = 0.f;
#pragma unroll
                for (int j = 0; j < 8; ++j) s += v[j] * v[j];
                const float r = rsqrtf(wave_sum(s) * (1.0f / HYW) + EPS);
                v4u o; o.x = pk2(v[0] * r, v[1] * r); o.y = pk2(v[2] * r, v[3] * r); o.z = pk2(v[4] * r, v[5] * r); o.w = pk2(v[6] * r, v[7] * r);
                *(v4u*)(MIX + (size_t)tok * DM + lane * 8) = o; }
            {   const v4u w = *(const v4u*)(YNA + (size_t)tok * 512 + lane * 8);
                float v[8] = {bflo(w.x), bfhi(w.x), bflo(w.y), bfhi(w.y), bflo(w.z), bfhi(w.z), bflo(w.w), bfhi(w.w)}; float s = 0.f;
#pragma unroll
                for (int j = 0; j < 8; ++j) s += v[j] * v[j];
                const float r = rsqrtf(wave_sum(s) * (1.0f / NAW) + EPS);
                v4u o; o.x = pk2(v[0] * r, v[1] * r); o.y = pk2(v[2] * r, v[3] * r); o.z = pk2(v[4] * r, v[5] * r); o.w = pk2(v[6] * r, v[7] * r);
                *(v4u*)(MIX + (size_t)tok * DM + 512 + lane * 8) = o; }
        }
    }
}

__device__ __forceinline__ void router_naive(Frame& F) {
    const bf16* H1 = WSP(bf16, WS_H1); const float* WR = WSP(float, WS_WR); float* rs1 = WSP(float, WS_RS1); float* GATE = WSP(float, WS_GATE); int* LIST = WSP(int, WS_LIST);
    const float* bg = F.in[20]; const float* be = F.in[22];
    const int gw = F.vcu * NWAVES + F.wave, NGW = F.G * NWAVES, lane = F.lane;
    for (int tok = gw; tok < M; tok += NGW) {
        const v4u wa = *(const v4u*)(H1 + (size_t)tok * DM + lane * 8), wb = *(const v4u*)(H1 + (size_t)tok * DM + 512 + lane * 8);
        float xv[16] = {bflo(wa.x), bfhi(wa.x), bflo(wa.y), bfhi(wa.y), bflo(wa.z), bfhi(wa.z), bflo(wa.w), bfhi(wa.w), bflo(wb.x), bfhi(wb.x), bflo(wb.y), bfhi(wb.y), bflo(wb.z), bfhi(wb.z), bflo(wb.w), bfhi(wb.w)};
        float ss = 0.f;
#pragma unroll
        for (int i = 0; i < 16; ++i) ss += xv[i] * xv[i];
        const float rstd = rsqrtf(wave_sum(ss) * (1.0f / DM) + EPS);
        if (lane == 0) rs1[tok] = rstd;
        float mylg = 0.f;
#pragma nounroll
        for (int j = 0; j < 36; ++j) {
            const f32x4 w0 = *(const f32x4*)(WR + j * 1024 + lane * 8), w1 = *(const f32x4*)(WR + j * 1024 + lane * 8 + 4), w2 = *(const f32x4*)(WR + j * 1024 + 512 + lane * 8), w3 = *(const f32x4*)(WR + j * 1024 + 512 + lane * 8 + 4);
            float a = xv[0] * w0[0] + xv[1] * w0[1] + xv[2] * w0[2] + xv[3] * w0[3] + xv[4] * w1[0] + xv[5] * w1[1] + xv[6] * w1[2] + xv[7] * w1[3]
                    + xv[8] * w2[0] + xv[9] * w2[1] + xv[10] * w2[2] + xv[11] * w2[3] + xv[12] * w3[0] + xv[13] * w3[1] + xv[14] * w3[2] + xv[15] * w3[3];
            const float sm = wave_sum(a) * rstd + (j < 4 ? bg[j] : be[j - 4]);
            if (lane == j) mylg = sm;
        }
        float lg[4];
#pragma unroll
        for (int j = 0; j < 4; ++j) lg[j] = __shfl(mylg, j);
        int g = 0; float gm = lg[0];
#pragma unroll
        for (int j = 1; j < 4; ++j) if (lg[j] > gm) { gm = lg[j]; g = j; }
        float gz = 0.f;
#pragma unroll
        for (int j = 0; j < 4; ++j) gz += __expf(lg[j] - gm);
        const float g_w = 1.f / gz;
        float e8[8];
#pragma unroll
        for (int i = 0; i < 8; ++i) e8[i] = __shfl(mylg, 4 + g * 8 + i);
        int i0 = 0; float m0 = e8[0];
#pragma unroll
        for (int i = 1; i < 8; ++i) if (e8[i] > m0) { m0 = e8[i]; i0 = i; }
        int i1 = -1; float m1 = -3.0e38f;
#pragma unroll
        for (int i = 0; i < 8; ++i) if (i != i0 && e8[i] > m1) { m1 = e8[i]; i1 = i; }
        const float r = __expf(m1 - m0); const float gate0 = g_w / (1.f + r), gate1 = g_w * r / (1.f + r);
        if (lane == 0) {
            const int e0 = g * 8 + i0, e1 = g * 8 + i1;
            const unsigned s0 = atomicAdd((unsigned*)(F.ctl + CW_CNT + 64 * e0), 1u); LIST[(size_t)e0 * LCAP + s0] = tok * 2; GATE[tok * 2] = gate0;
            const unsigned s1 = atomicAdd((unsigned*)(F.ctl + CW_CNT + 64 * e1), 1u); LIST[(size_t)e1 * LCAP + s1] = tok * 2 + 1; GATE[tok * 2 + 1] = gate1;
        }
    }
}

__device__ __forceinline__ float siluf_(float v) { return v / (1.f + __expf(-v)); }
__device__ __forceinline__ void moe_naive(Frame& F) {
    LAS int* tab = (LAS int*)(F.lds + TAB_OFF);
    LAS float* xs = (LAS float*)F.lds;
    LAS float* hs = xs + 8 * 1024;
    LAS int* tk = (LAS int*)(hs + 8 * 512);
    const bf16* H1 = WSP(bf16, WS_H1); const float* rs1 = WSP(float, WS_RS1); const float* GATE = WSP(float, WS_GATE); const int* LIST = WSP(int, WS_LIST);
    const bf16* W13 = WSP(bf16, WS_W13); const bf16* W2 = WSP(bf16, WS_W2); bf16* YK0 = WSP(bf16, WS_YK0); bf16* YK1 = WSP(bf16, WS_YK1);
    const int tid = F.tid;
    __syncthreads();
    if (tid < NE) tab[40 + tid] = (int)__hip_atomic_load(F.ctl + CW_CNT + 64 * tid, RLX_AGENT);
    __syncthreads();
    if (tid == 0) { int s = 0; for (int e = 0; e < NE; ++e) { tab[e] = s; s += (tab[40 + e] + 7) >> 3; } tab[NE] = s; }
    __syncthreads();
    const int total = tab[NE];
    for (int unit = blockIdx.x; unit < total; unit += F.G) {
        int e = 0;
        for (int j = 1; j < NE; ++j) if (tab[j] <= unit) e = j;
        const int ch = unit - tab[e], ne = tab[40 + e];
        __syncthreads();
        if (tid < 8) { const int idx = ch * 8 + tid; tk[tid] = idx < ne ? LIST[(size_t)e * LCAP + idx] : -1; }
        __syncthreads();
        for (int i = tid; i < 8 * 1024; i += 512) { const int r = i >> 10, k = i & 1023; const int t = tk[r]; xs[i] = t >= 0 ? bf2f(H1[(size_t)(t >> 1) * DM + k]) : 0.f; }
        __syncthreads();
        {
            const int c1 = (tid >> 2) * 8 + (tid & 3);
            const bf16* w1r = W13 + ((size_t)e * 1024 + c1) * DM; const bf16* w3r = w1r + 4 * DM;
            float a1[8], a3[8];
#pragma unroll
            for (int r = 0; r < 8; ++r) { a1[r] = 0.f; a3[r] = 0.f; }
            for (int k8 = 0; k8 < 128; ++k8) {
                const v4u u1 = *(const v4u*)(w1r + k8 * 8), u3 = *(const v4u*)(w3r + k8 * 8);
                const float p1[8] = {bflo(u1.x), bfhi(u1.x), bflo(u1.y), bfhi(u1.y), bflo(u1.z), bfhi(u1.z), bflo(u1.w), bfhi(u1.w)};
                const float p3[8] = {bflo(u3.x), bfhi(u3.x), bflo(u3.y), bfhi(u3.y), bflo(u3.z), bfhi(u3.z), bflo(u3.w), bfhi(u3.w)};
#pragma unroll
                for (int r = 0; r < 8; ++r) { const f32x4 xa = *(const LAS f32x4*)(xs + r * 1024 + k8 * 8), xb = *(const LAS f32x4*)(xs + r * 1024 + k8 * 8 + 4);
                    a1[r] += xa[0] * p1[0] + xa[1] * p1[1] + xa[2] * p1[2] + xa[3] * p1[3] + xb[0] * p1[4] + xb[1] * p1[5] + xb[2] * p1[6] + xb[3] * p1[7];
                    a3[r] += xa[0] * p3[0] + xa[1] * p3[1] + xa[2] * p3[2] + xa[3] * p3[3] + xb[0] * p3[4] + xb[1] * p3[5] + xb[2] * p3[6] + xb[3] * p3[7]; }
            }
#pragma unroll
            for (int r = 0; r < 8; ++r) { const int t = tk[r]; const float rs = t >= 0 ? rs1[t >> 1] : 0.f; hs[r * 512 + tid] = bfr(siluf_(a1[r] * rs) * (a3[r] * rs)); }
        }
        __syncthreads();
#pragma unroll
        for (int cc = 0; cc < 2; ++cc) { const int c = tid * 2 + cc; const bf16* w2r = W2 + ((size_t)e * DM + c) * DE;
            float a[8];
#pragma unroll
            for (int r = 0; r < 8; ++r) a[r] = 0.f;
            for (int k8 = 0; k8 < 64; ++k8) { const v4u u = *(const v4u*)(w2r + k8 * 8);
                const float p[8] = {bflo(u.x), bfhi(u.x), bflo(u.y), bfhi(u.y), bflo(u.z), bfhi(u.z), bflo(u.w), bfhi(u.w)};
#pragma unroll
                for (int r = 0; r < 8; ++r) { const f32x4 xa = *(const LAS f32x4*)(hs + r * 512 + k8 * 8), xb = *(const LAS f32x4*)(hs + r * 512 + k8 * 8 + 4);
                    a[r] += xa[0] * p[0] + xa[1] * p[1] + xa[2] * p[2] + xa[3] * p[3] + xb[0] * p[4] + xb[1] * p[5] + xb[2] * p[6] + xb[3] * p[7]; } }
#pragma unroll
            for (int r = 0; r < 8; ++r) { const int t = tk[r]; if (t >= 0) { bf16* Y = (t & 1) ? YK1 : YK0; Y[(size_t)(t >> 1) * DM + c] = (bf16)f2bf(a[r] * GATE[t]); } }
        }
    }
}

__device__ __forceinline__ void combine(Frame& F) {
    const bf16* H1 = WSP(bf16, WS_H1); const bf16* Y0 = WSP(bf16, WS_YK0); const bf16* Y1 = WSP(bf16, WS_YK1); bf16* H2 = WSP(bf16, WS_H2); float* rs2 = WSP(float, WS_RS2);
    const int gw = F.vcu * NWAVES + F.wave, NGW = F.G * NWAVES, lane = F.lane;
    for (int tok = gw; tok < M; tok += NGW) {
        float ss = 0.f;
#pragma unroll
        for (int hh = 0; hh < 2; ++hh) { const size_t o = (size_t)tok * DM + hh * 512 + lane * 8;
            const v4u a = *(const v4u*)(H1 + o), b = *(const v4u*)(Y0 + o), c = *(const v4u*)(Y1 + o);
            float v[8] = {bflo(a.x) + bflo(b.x) + bflo(c.x), bfhi(a.x) + bfhi(b.x) + bfhi(c.x), bflo(a.y) + bflo(b.y) + bflo(c.y), bfhi(a.y) + bfhi(b.y) + bfhi(c.y),
                          bflo(a.z) + bflo(b.z) + bflo(c.z), bfhi(a.z) + bfhi(b.z) + bfhi(c.z), bflo(a.w) + bflo(b.w) + bflo(c.w), bfhi(a.w) + bfhi(b.w) + bfhi(c.w)};
            v4u w; w.x = pk2(v[0], v[1]); w.y = pk2(v[2], v[3]); w.z = pk2(v[4], v[5]); w.w = pk2(v[6], v[7]);
            *(v4u*)(H2 + o) = w;
            const float q[8] = {bflo(w.x), bfhi(w.x), bflo(w.y), bfhi(w.y), bflo(w.z), bfhi(w.z), bflo(w.w), bfhi(w.w)};
#pragma unroll
            for (int j = 0; j < 8; ++j) ss += q[j] * q[j]; }
        ss = wave_sum(ss);
        if (lane == 0) rs2[tok] = rsqrtf(ss * (1.0f / DM) + EPS);
    }
}
__device__ __forceinline__ void final_norm(Frame& F) {
    const bf16* H3 = WSP(bf16, WS_H3); const float* gf = F.in[29]; float* out = F.out;
    const int gw = F.vcu * NWAVES + F.wave, NGW = F.G * NWAVES, lane = F.lane;
    for (int tok = gw; tok < M; tok += NGW) {
        float v[16]; float ss = 0.f;
#pragma unroll
        for (int hh = 0; hh < 2; ++hh) { const v4u a = *(const v4u*)(H3 + (size_t)tok * DM + hh * 512 + lane * 8);
            v[hh * 8 + 0] = bflo(a.x); v[hh * 8 + 1] = bfhi(a.x); v[hh * 8 + 2] = bflo(a.y); v[hh * 8 + 3] = bfhi(a.y); v[hh * 8 + 4] = bflo(a.z); v[hh * 8 + 5] = bfhi(a.z); v[hh * 8 + 6] = bflo(a.w); v[hh * 8 + 7] = bfhi(a.w); }
#pragma unroll
        for (int j = 0; j < 16; ++j) ss += v[j] * v[j];
        const float r = rsqrtf(wave_sum(ss) * (1.0f / DM) + EPS);
#pragma unroll
        for (int hh = 0; hh < 2; ++hh) { const int c0 = hh * 512 + lane * 8; const f32x4 g0 = *(const f32x4*)(gf + c0), g1 = *(const f32x4*)(gf + c0 + 4);
            f32x4 o0 = {v[hh * 8 + 0] * r * g0[0], v[hh * 8 + 1] * r * g0[1], v[hh * 8 + 2] * r * g0[2], v[hh * 8 + 3] * r * g0[3]};
            f32x4 o1 = {v[hh * 8 + 4] * r * g1[0], v[hh * 8 + 5] * r * g1[1], v[hh * 8 + 6] * r * g1[2], v[hh * 8 + 7] * r * g1[3]};
            *(f32x4*)(out + (size_t)tok * DM + c0) = o0; *(f32x4*)(out + (size_t)tok * DM + c0 + 4) = o1; }
    }
}
__device__ __forceinline__ void hyena_phase(Frame& F) {
#if HY_NAIVE
    hyena_naive(F);
#else
    hyena_mfma(F);
#endif
}
__device__ __forceinline__ void natten_phase(Frame& F) {
#if NA_NAIVE
    natten_naive(F);
#else
    natten_mfma(F);
#endif
}
__device__ __forceinline__ void router_phase(Frame& F) {
#if RT_NAIVE
    router_naive(F);
#else
    router_mfma(F);
#endif
}
__device__ __forceinline__ void moe_phase_a(Frame& F) {
#if MOE_NAIVE
    moe_naive(F);
#else
    moe_gemm1(F);
#endif
}
__device__ __forceinline__ void moe_phase_b(Frame& F) {
#if MOE_NAIVE
    (void)F;
#else
    moe_gemm2(F);
#endif
}
constexpr int N_PHASES = 11;
constexpr int N_LAUNCHES = MK_N_LAUNCHES;
struct Args { const float* in[30]; float* out; unsigned char* ws; int ph_lo, ph_hi; };
#ifndef PG8_SP2
#define PG8_SP2 true
#endif
#ifndef PG8_ALIGN
#define PG8_ALIGN true
#endif
__global__ void __launch_bounds__(NWAVES * 64, 2) fwd_kernel(Args args) {
    extern __shared__ __attribute__((aligned(16))) unsigned char lds[];
    Frame F;
    F.lds = (LAS unsigned char*)lds;
    F.MISC = (volatile LAS unsigned*)(F.lds + MISC_OFF);
    F.tid = threadIdx.x; F.lane = F.tid & 63; F.wave = __builtin_amdgcn_readfirstlane(F.tid >> 6);
    F.G = gridDim.x; { const int bx = blockIdx.x; F.vcu = (F.G % 8 == 0) ? (bx % 8) * (F.G / 8) + bx / 8 : bx; }
    F.ws = args.ws; F.in = args.in; F.out = args.out;
    F.ctl = (gu32*)(F.ws + WS_CTL);
    for (int u = F.tid; u < (LDS_BYTES - LDSCTL_OFF) / 4; u += NWAVES * 64) ((LAS unsigned*)(F.lds + LDSCTL_OFF))[u] = 0u;
    __syncthreads();
    XcdBarrier bar; bar.bar = (unsigned*)(F.ctl + CW_BAR); bar.x = 0; bar.st = nullptr;
    if (N_LAUNCHES == 1) bar = xcd_barrier_post((unsigned*)(F.ctl + CW_BAR), F.MISC + 8);
#define GRID_BAR() do { if (N_LAUNCHES == 1) xcd_barrier(bar); } while (0)
    const int lo = args.ph_lo, hi = args.ph_hi;
#ifndef PH_MASK
#define PH_MASK 0xFFFF
#endif
#define IN(k) (((PH_MASK >> (k)) & 1) && lo <= (k) && (k) < hi)
#define BOTH(k) (IN(k) && IN((k) + 1))

    if (IN(0)) { p0_prologue(F); if (BOTH(0)) GRID_BAR(); }

    if (IN(1)) {
        { DenseSrc S; S.set(WSP(bf16, WS_XB), WSP(bf16, WS_WIN), M, UTR, DM, F.G, (int)blockIdx.x);
          EpiUT E{WSP(bf16, WS_UT), WSP(float, WS_RSX)};
          pg8::gemm_phase<EpiUT, DenseSrc, false, false, PG8_ALIGN, PG8_SP2>(F.lds + RING_OFF, DM, S, E); }
        { DenseSrc S; S.set(WSP(bf16, WS_XB), WSP(bf16, WS_WIN) + (size_t)UTR * DM, M, 1024, DM, F.G, (int)blockIdx.x);
          EpiQK E{WSP(bf16, WS_Q), WSP(bf16, WS_K), WSP(float, WS_RSX)};
          pg8::gemm_phase<EpiQK, DenseSrc, true, false, PG8_ALIGN, PG8_SP2>(F.lds + RING_OFF, DM, S, E); }
        if (BOTH(1)) GRID_BAR();
    }

    if (IN(2)) { hyena_phase(F); __syncthreads(); natten_phase(F); if (BOTH(2)) GRID_BAR(); }

    if (IN(3)) { mixnorm(F); if (BOTH(3)) GRID_BAR(); }

    if (IN(4)) {
        DenseSrc S; S.set(WSP(bf16, WS_MIX), WSP(bf16, WS_WOUT), M, DM, DM, F.G, (int)blockIdx.x);
        EpiH1 E{WSP(bf16, WS_H1), F.in[0]};
        pg8::gemm_phase<EpiH1, DenseSrc, true, false, PG8_ALIGN, PG8_SP2>(F.lds + RING_OFF, DM, S, E);
        if (BOTH(4)) GRID_BAR();
    }

    if (IN(5)) { router_phase(F); if (BOTH(5)) GRID_BAR(); }

    if (IN(6)) { moe_phase_a(F); if (BOTH(6)) GRID_BAR(); }

    if (IN(7)) { moe_phase_b(F); if (BOTH(7)) GRID_BAR(); }

    if (IN(8)) {
        combine(F);
        __syncthreads();
        DenseSrc S; S.set(WSP(bf16, WS_PB), WSP(bf16, WS_WP), M, DM, PLE, F.G, (int)blockIdx.x);
        EpiPL E{WSP(bf16, WS_PL)};
        pg8::gemm_phase<EpiPL, DenseSrc, true, false, PG8_ALIGN, PG8_SP2>(F.lds + RING_OFF, PLE, S, E);
        if (BOTH(8)) GRID_BAR();
    }

    if (IN(9)) {
        DenseSrc S; S.set(WSP(bf16, WS_H2), WSP(bf16, WS_WG), M, DM, DM, F.G, (int)blockIdx.x);
        EpiPLE E{WSP(bf16, WS_H3), WSP(bf16, WS_H2), WSP(bf16, WS_PL), WSP(float, WS_RS2)};
        pg8::gemm_phase<EpiPLE, DenseSrc, true, false, PG8_ALIGN, PG8_SP2>(F.lds + RING_OFF, DM, S, E);
        if (BOTH(9)) GRID_BAR();
    }

    if (IN(10)) { final_norm(F); }
#undef IN
#undef BOTH
}

extern "C" void kernel_launch(void* const* d_in, const int* in_sizes, int n_in, void* d_out, int out_size, void* d_ws, size_t ws_size, hipStream_t stream) {
    static int grid = 0;
    if (grid == 0) {
        if (n_in != 30 || in_sizes[0] != M * DM || out_size != M * DM || ws_size < WS_END) { fprintf(stderr, "kernel_launch: unexpected shapes (n_in %d, in0 %d, out %d, ws %zu); nothing launched\n", n_in, n_in > 0 ? in_sizes[0] : -1, out_size, ws_size); grid = -1; return; }
        int dev = 0, cus = 0, per_cu = 0;
        if (hipGetDevice(&dev) != hipSuccess || hipDeviceGetAttribute(&cus, hipDeviceAttributeMultiprocessorCount, dev) != hipSuccess) { fprintf(stderr, "kernel_launch: device query failed\n"); grid = -1; return; }
        if (hipFuncSetAttribute((const void*)fwd_kernel, hipFuncAttributeMaxDynamicSharedMemorySize, LDS_BYTES) != hipSuccess) { fprintf(stderr, "kernel_launch: hipFuncSetAttribute failed\n"); grid = -1; return; }
        if (hipOccupancyMaxActiveBlocksPerMultiprocessor(&per_cu, (const void*)fwd_kernel, NWAVES * 64, LDS_BYTES) != hipSuccess || per_cu < 1) { fprintf(stderr, "kernel_launch: occupancy query reports %d\n", per_cu); }
        (void)hipGetLastError();
        grid = cus;
    }
    if (grid < 0) return;
    if (hipMemsetAsync((char*)d_ws + WS_CTL, 0, CTL_ZERO_BYTES, stream) != hipSuccess) { fprintf(stderr, "kernel_launch: memset failed\n"); return; }
    Args a{};
    for (int i = 0; i < 30; ++i) a.in[i] = (const float*)d_in[i];
    a.out = (float*)d_out; a.ws = (unsigned char*)d_ws;
    if (N_LAUNCHES == 1) {
        a.ph_lo = 0; a.ph_hi = N_PHASES;
        hipLaunchKernelGGL(fwd_kernel, dim3(grid), dim3(NWAVES * 64), LDS_BYTES, stream, a);
    } else {
        for (int li = 0; li < N_PHASES; ++li) {
#if MOE_NAIVE
            if (li == 7) continue;
#endif
            a.ph_lo = li; a.ph_hi = li + 1;
            hipLaunchKernelGGL(fwd_kernel, dim3(grid), dim3(NWAVES * 64), LDS_BYTES, stream, a);
        }
    }
    const hipError_t le = hipPeekAtLastError();
    if (le != hipSuccess) fprintf(stderr, "kernel_launch: launch failed: %s\n", hipGetErrorName(le));
}
```

```cpp
#define MK_N_LAUNCHES 1
#include <hip/hip_runtime.h>
#include <cstdio>
#include <cstdint>
#ifndef MK_N_LAUNCHES
#define MK_N_LAUNCHES 1
#endif
#ifndef HY_NAIVE
#define HY_NAIVE 1
#endif
#ifndef NA_NAIVE
#define NA_NAIVE 1
#endif
#ifndef RT_NAIVE
#define RT_NAIVE 1
#endif
#ifndef MOE_NAIVE
#define MOE_NAIVE 1
#endif
namespace pg8 {
#define PG8_LAS __attribute__((address_space(3)))
typedef unsigned short bf16_t;
typedef short bf16x8 __attribute__((ext_vector_type(8)));
typedef float f32x4 __attribute__((ext_vector_type(4)));
typedef float f32x2 __attribute__((ext_vector_type(2)));
typedef unsigned u32x4 __attribute__((ext_vector_type(4)));
typedef unsigned u32x2 __attribute__((ext_vector_type(2)));
constexpr int BM = 256, BK = 64, HALF = 128, HTB = HALF * BK * 2  , STAGE_BYTES = 8 * HTB, NXCD = 8, WGM = 8;

__host__ __device__ __forceinline__ int lds_byte(int r, int c) { const int st = (r >> 4) * 2 + (c >> 5), rr = r & 15, cc = c & 31, ob = rr * 64 + cc * 2; return st * 1024 + (ob ^ (((ob >> 9) & 1) << 5)); }
__host__ __device__ __forceinline__ void stage_rc(int b, int& R, int& C) { const int st = b / 1024, sb = b % 1024, swz = sb ^ (((sb >> 9) & 1) << 5); R = (st >> 1) * 16 + swz / 64; C = (st & 1) * 32 + (swz % 64) / 2; }
__host__ __device__ __forceinline__ int perm32(int rho) { const int n = rho >> 4, i = rho & 15; return 8 * (i >> 2) + 4 * n + (i & 3); }

struct Unit { int pm, pn, e, aux; };

struct StaticOrder {
    int nM, nN, nwg, G, c;
    __host__ __device__ void init(int M, int N, int G_, int c_) { nM = M / BM; nN = N / BM; nwg = nM * nN; G = G_; c = c_; }
    __host__ __device__ bool next(int i, Unit& u) const {
        const long L = (long)i * G + c; if (L >= nwg) return false;
        int wgid = (int)L; { const int q = nwg / NXCD, r = nwg % NXCD, xcd = wgid % NXCD, off = wgid / NXCD; wgid = (xcd < r ? xcd * (q + 1) : r * (q + 1) + (xcd - r) * q) + off; }
        const int nig = WGM * nN, gid = wgid / nig, fm = gid * WGM, gsz = (nM - fm) < WGM ? (nM - fm) : WGM;
        u.pm = fm + ((wgid % nig) % gsz); u.pn = (wgid % nig) / gsz; u.e = 0; u.aux = 0; return true;
    }
};

__device__ __forceinline__ unsigned cvt_pk_bf16(float lo, float hi) { unsigned r; asm volatile("v_cvt_pk_bf16_f32 %0, %1, %2" : "=v"(r) : "v"(lo), "v"(hi)); return r; }

template <class Epi, class Src, bool TACC, bool GATHER, bool ALIGN_EPI, bool SP2>
__device__ __forceinline__ void gemm_phase(PG8_LAS unsigned char* lds, const int K, const Src& S, const Epi& E) {
    const int tid = threadIdx.x, wid = __builtin_amdgcn_readfirstlane(tid >> 6), lane = tid & 63, wr = wid >> 2, wc = wid & 3, fr = lane & 15, fq = lane >> 4;
    const int nt = K / BK;
    int Rr[2], Cc[2]; unsigned voffB[2];
#pragma unroll
    for (int i = 0; i < 2; ++i) { int R, C; stage_rc(tid * 16 + i * 8192, R, C); const int Rb = Epi::PERM ? ((R & ~31) + perm32(R & 31)) : R;
        Rr[i] = R; Cc[i] = C; voffB[i] = (unsigned)(Rb * K + C) * 2u; }
    const size_t kstep = (size_t)(BK * 2);
    const size_t hstep = (size_t)HALF * K * 2;
    const unsigned ldsw = (unsigned)wid * 1024u;
    const int aoff = lds_byte(wr * 64 + fr, fq * 8), boff = lds_byte(wc * 32 + fr, fq * 8);
#define PG8_SA(b, h) (((b) * 2 + (h)) * HTB)
#define PG8_SB(b, h) ((4 + (b) * 2 + (h)) * HTB)
#define PG8_STAGE(bufoff, gbase, voff) do { _Pragma("unroll") for (int _i = 0; _i < 2; ++_i) \
        __builtin_amdgcn_global_load_lds((const unsigned*)((const char*)(gbase) + (voff)[_i]), (PG8_LAS unsigned*)(lds + (bufoff) + ldsw + _i * 8192), 16, 0, 0); } while (0)
#define PG8_LDA(dst, b, h) do { _Pragma("unroll") for (int m = 0; m < 4; ++m) _Pragma("unroll") for (int k = 0; k < 2; ++k) dst[m][k] = *(const PG8_LAS bf16x8*)(lds + PG8_SA(b, h) + aoff + m * 2048 + k * 1024); } while (0)
#define PG8_LDB(dst, b, h) do { _Pragma("unroll") for (int n = 0; n < 2; ++n) _Pragma("unroll") for (int k = 0; k < 2; ++k) dst[n][k] = *(const PG8_LAS bf16x8*)(lds + PG8_SB(b, h) + boff + n * 2048 + k * 1024); } while (0)
#define PG8_MMA(ai, bj, At, Bt) do { __builtin_amdgcn_s_setprio(1); _Pragma("unroll") for (int m = 0; m < 4; ++m) _Pragma("unroll") for (int n = 0; n < 2; ++n) _Pragma("unroll") for (int k = 0; k < 2; ++k) \
        acc[ai][bj][m][n] = TACC ? __builtin_amdgcn_mfma_f32_16x16x32_bf16(Bt[n][k], At[m][k], acc[ai][bj][m][n], 0, 0, 0) \
                                 : __builtin_amdgcn_mfma_f32_16x16x32_bf16(At[m][k], Bt[n][k], acc[ai][bj][m][n], 0, 0, 0); __builtin_amdgcn_s_setprio(0); } while (0)
#define PG8_WAIT_V(n) asm volatile("s_waitcnt vmcnt(" #n ")" ::: "memory")
#define PG8_WAIT_L(n) asm volatile("s_waitcnt lgkmcnt(" #n ")" ::: "memory")
#define PG8_BAR __builtin_amdgcn_s_barrier()
#define PG8_SCHED __builtin_amdgcn_sched_barrier(0)
    Unit cur, nxt; int ui = 0;
    if (!S.next(0, cur)) return;
    f32x4 acc[2][2][4][2];
#pragma unroll
    for (int a = 0; a < 2; ++a)
#pragma unroll
        for (int b = 0; b < 2; ++b)
#pragma unroll
            for (int m = 0; m < 4; ++m)
#pragma unroll
                for (int n = 0; n < 2; ++n) acc[a][b][m][n] = (f32x4){0.f, 0.f, 0.f, 0.f};
    bf16x8 At[4][2], B0[2][2], B1[2][2];
    unsigned offA[2][2], nOffA[2][2];
    S.aoff(cur, K, Rr, Cc, offA);
    const char* cA = S.abase(cur); const char* cB = S.bbase(cur);
    if constexpr (SP2) {
        PG8_STAGE(PG8_SB(0, 0), cB, voffB); PG8_STAGE(PG8_SB(0, 1), cB + hstep, voffB); PG8_STAGE(PG8_SA(0, 0), cA, offA[0]); PG8_STAGE(PG8_SA(0, 1), cA, offA[1]);
        if (wr == 1) PG8_BAR;
        PG8_WAIT_V(2); PG8_BAR;
        PG8_STAGE(PG8_SB(1, 0), cB + kstep, voffB); PG8_STAGE(PG8_SA(1, 0), cA + kstep, offA[0]); PG8_STAGE(PG8_SB(1, 1), cB + hstep + kstep, voffB);
        PG8_WAIT_V(6); PG8_BAR;
    } else {
        PG8_STAGE(PG8_SB(0, 0), cB, voffB); PG8_STAGE(PG8_SA(0, 0), cA, offA[0]); PG8_STAGE(PG8_SB(0, 1), cB + hstep, voffB); PG8_STAGE(PG8_SA(0, 1), cA, offA[1]);
        if (wr == 1) PG8_BAR;
        PG8_WAIT_V(4); PG8_BAR;
        PG8_STAGE(PG8_SB(1, 0), cB + kstep, voffB); PG8_STAGE(PG8_SA(1, 0), cA + kstep, offA[0]); PG8_STAGE(PG8_SB(1, 1), cB + hstep + kstep, voffB);
        PG8_WAIT_V(6); PG8_BAR;
    }
    for (;;) {
        const bool has_next = S.next(ui + 1, nxt);
        const char* nA = has_next ? S.abase(nxt) : cA; const char* nB = has_next ? S.bbase(nxt) : cB;
        if constexpr (GATHER) {
            if (has_next) S.aoff(nxt, K, Rr, Cc, nOffA);
            else {
#pragma unroll
                for (int h = 0; h < 2; ++h)
#pragma unroll
                    for (int i = 0; i < 2; ++i) nOffA[h][i] = offA[h][i]; }
        }
#pragma nounroll
        for (int t = 0; t < nt; t += 2) {
            const bool last = (t == nt - 2);
            const char* a1 = cA + (size_t)(t + 1) * kstep;
            const char* a2 = last ? nA : cA + (size_t)(t + 2) * kstep; const char* b2 = last ? nB : cB + (size_t)(t + 2) * kstep;
            const char* a3 = a2 + kstep; const char* b3 = b2 + kstep;
            unsigned o2[2][2];
#pragma unroll
            for (int h = 0; h < 2; ++h)
#pragma unroll
                for (int i = 0; i < 2; ++i) o2[h][i] = (GATHER && last) ? nOffA[h][i] : offA[h][i];
            if constexpr (SP2) {
            PG8_LDB(B0, 0, 0); PG8_LDB(B1, 0, 1); PG8_SCHED; PG8_LDA(At, 0, 0); PG8_STAGE(PG8_SA(1, 1), a1, offA[1]);
            PG8_WAIT_V(8); PG8_WAIT_L(0); PG8_BAR; PG8_MMA(0, 0, At, B0); PG8_MMA(0, 1, At, B1); PG8_BAR; PG8_SCHED;
            PG8_LDA(At, 0, 1); PG8_STAGE(PG8_SB(0, 0), b2, voffB); PG8_STAGE(PG8_SB(0, 1), b2 + hstep, voffB); PG8_STAGE(PG8_SA(0, 0), a2, o2[0]);
            PG8_WAIT_V(8); PG8_WAIT_L(0); PG8_BAR; PG8_MMA(1, 0, At, B0); PG8_MMA(1, 1, At, B1); PG8_BAR; PG8_SCHED;
            PG8_LDB(B0, 1, 0); PG8_LDB(B1, 1, 1); PG8_SCHED; PG8_LDA(At, 1, 0); PG8_STAGE(PG8_SA(0, 1), a2, o2[1]);
            PG8_WAIT_V(8); PG8_WAIT_L(0); PG8_BAR; PG8_MMA(0, 0, At, B0); PG8_MMA(0, 1, At, B1); PG8_BAR; PG8_SCHED;
            PG8_LDA(At, 1, 1); PG8_STAGE(PG8_SB(1, 0), b3, voffB); PG8_STAGE(PG8_SB(1, 1), b3 + hstep, voffB); PG8_STAGE(PG8_SA(1, 0), a3, o2[0]);
            PG8_WAIT_V(8); PG8_WAIT_L(0); PG8_BAR; PG8_MMA(1, 0, At, B0); PG8_MMA(1, 1, At, B1); PG8_BAR; PG8_SCHED;
            } else {
            PG8_LDB(B0, 0, 0); PG8_SCHED; PG8_LDA(At, 0, 0); PG8_STAGE(PG8_SA(1, 1), a1, offA[1]);
            PG8_WAIT_L(8); PG8_BAR; PG8_WAIT_L(0); PG8_MMA(0, 0, At, B0); PG8_BAR; PG8_SCHED;
            PG8_LDB(B1, 0, 1); PG8_STAGE(PG8_SB(0, 0), b2, voffB);
            PG8_BAR; PG8_WAIT_L(0); PG8_MMA(0, 1, At, B1); PG8_BAR;
            PG8_LDA(At, 0, 1); PG8_STAGE(PG8_SA(0, 0), a2, o2[0]);
            PG8_BAR; PG8_WAIT_L(0); PG8_MMA(1, 0, At, B0); PG8_BAR; PG8_SCHED;
            PG8_STAGE(PG8_SB(0, 1), b2 + hstep, voffB);
            PG8_WAIT_V(6); PG8_BAR; PG8_MMA(1, 1, At, B1); PG8_BAR;
            PG8_LDB(B0, 1, 0); PG8_SCHED; PG8_LDA(At, 1, 0); PG8_STAGE(PG8_SA(0, 1), a2, o2[1]);
            PG8_WAIT_L(8); PG8_BAR; PG8_WAIT_L(0); PG8_MMA(0, 0, At, B0); PG8_BAR; PG8_SCHED;
            PG8_LDB(B1, 1, 1); PG8_STAGE(PG8_SB(1, 0), b3, voffB);
            PG8_BAR; PG8_WAIT_L(0); PG8_MMA(0, 1, At, B1); PG8_BAR;
            PG8_LDA(At, 1, 1); PG8_STAGE(PG8_SA(1, 0), a3, o2[0]);
            PG8_BAR; PG8_WAIT_L(0); PG8_MMA(1, 0, At, B0); PG8_BAR; PG8_SCHED;
            PG8_STAGE(PG8_SB(1, 1), b3 + hstep, voffB);
            PG8_WAIT_V(6); PG8_BAR; PG8_MMA(1, 1, At, B1); PG8_BAR;
            }
        }
        if constexpr (ALIGN_EPI) { if (wr == 0) PG8_BAR; }
        E(acc, cur, wr, wc, fr, fq);
        if (!has_next) break;
#pragma unroll
        for (int a = 0; a < 2; ++a)
#pragma unroll
            for (int b = 0; b < 2; ++b)
#pragma unroll
                for (int m = 0; m < 4; ++m)
#pragma unroll
                    for (int n = 0; n < 2; ++n) acc[a][b][m][n] = (f32x4){0.f, 0.f, 0.f, 0.f};
        cur = nxt; cA = nA; cB = nB; ++ui;
        if constexpr (GATHER) {
#pragma unroll
            for (int h = 0; h < 2; ++h)
#pragma unroll
                for (int i = 0; i < 2; ++i) offA[h][i] = nOffA[h][i]; }
        if constexpr (ALIGN_EPI) { if (wr == 1) PG8_BAR; }
    }
    PG8_WAIT_V(0);
    if constexpr (!ALIGN_EPI) { if (wr == 0) PG8_BAR; }
    PG8_BAR;
#undef PG8_SA
#undef PG8_SB
#undef PG8_STAGE
#undef PG8_LDA
#undef PG8_LDB
#undef PG8_MMA
#undef PG8_WAIT_V
#undef PG8_WAIT_L
#undef PG8_BAR
#undef PG8_SCHED
}
}
constexpr int NB = 16, SEQ = 2048, DM = 1024, M = NB * SEQ, PLE = 256;
constexpr int HYW = 512, NAW = 512, NH = 8, HD = 64, UTR = 2048;
constexpr int NE = 32, DE = 512, LCAP = M;
constexpr int GSTR = 4104;
constexpr float EPS = 1e-6f;
constexpr int NWAVES = 8;

constexpr size_t MiB = 1u << 20, KiB = 1u << 10;
constexpr size_t WS_CTL = 0, CTL_ZERO_BYTES = 1 * MiB;
constexpr size_t WS_RSX = 1 * MiB, WS_RS1 = WS_RSX + 128 * KiB, WS_RS2 = WS_RS1 + 128 * KiB;
constexpr size_t WS_WR = 1 * MiB + 512 * KiB;
constexpr size_t WS_GATE = 2 * MiB;
constexpr size_t WS_LIST = 4 * MiB;
constexpr size_t WS_WIN = 8 * MiB, WS_WOUT = 14 * MiB, WS_WG = 16 * MiB, WS_WP = 18 * MiB;
constexpr size_t WS_HYK = 20 * MiB;
constexpr size_t WS_W13 = 30 * MiB, WS_W2 = 94 * MiB;
constexpr size_t WS_PB = 126 * MiB;
constexpr size_t WS_A1 = 142 * MiB;
constexpr size_t WS_A2 = 206 * MiB;
constexpr size_t WS_A3 = 334 * MiB;
constexpr size_t WS_A4 = 414 * MiB;
constexpr size_t WS_END = 478 * MiB;
constexpr size_t WS_XB = WS_A1, WS_MIX = WS_A1, WS_YK0 = WS_A1, WS_H3 = WS_A1;
constexpr size_t WS_UT = WS_A2, WS_H1 = WS_A2, WS_H2 = WS_A2 + 64 * MiB;
constexpr size_t WS_Q = WS_A3, WS_K = WS_A3 + 32 * MiB, WS_HID = WS_A3, WS_PL = WS_A3;
constexpr size_t WS_YT = WS_A4, WS_YNA = WS_A4 + 32 * MiB, WS_YK1 = WS_A4;
static_assert(WS_HYK + (size_t)1024 * GSTR * 2 <= WS_W13 && WS_A3 + (size_t)(2 * M + NE * 256) * DE * 2 <= WS_A4, "d_ws map");
constexpr int CW_TMO = 0, CW_CODE = 1;
constexpr int CW_BAR = 4096;
constexpr int CW_CNT = 8192;
constexpr int RING_OFF = 0, RING_BYTES = 131072;
constexpr int LDSCTL_OFF = RING_BYTES, TAB_OFF = LDSCTL_OFF, MISC_OFF = LDSCTL_OFF + 320;
constexpr int LDS_BYTES = 147456;

#define GAS __attribute__((address_space(1)))
#define LAS __attribute__((address_space(3)))
typedef unsigned short bf16;
typedef unsigned v4u __attribute__((ext_vector_type(4)));
typedef unsigned v2u __attribute__((ext_vector_type(2)));
typedef float f32x4 __attribute__((ext_vector_type(4)));
typedef short bf16x8 __attribute__((ext_vector_type(8)));
typedef GAS unsigned gu32;
#define RLX_AGENT __ATOMIC_RELAXED, __HIP_MEMORY_SCOPE_AGENT
#define LDS_WAIT() asm volatile("s_waitcnt lgkmcnt(0)" ::: "memory")
#define VM_WAIT() asm volatile("s_waitcnt vmcnt(0)" ::: "memory")
__device__ __forceinline__ unsigned f2bf(float f) { unsigned u = __builtin_bit_cast(unsigned, f); return (u + 0x7fffu + ((u >> 16) & 1u)) >> 16; }
__device__ __forceinline__ unsigned pk2(float lo, float hi) { return f2bf(lo) | (f2bf(hi) << 16); }
__device__ __forceinline__ float bf2f(unsigned b) { return __builtin_bit_cast(float, b << 16); }
__device__ __forceinline__ float bflo(unsigned w) { return __builtin_bit_cast(float, w << 16); }
__device__ __forceinline__ float bfhi(unsigned w) { return __builtin_bit_cast(float, w & 0xffff0000u); }
__device__ __forceinline__ float bfr(float f) { return bf2f(f2bf(f)); }
__device__ __forceinline__ float wave_sum(float v) {
#pragma unroll
    for (int o = 1; o < 64; o <<= 1) v += __shfl_xor(v, o);
    return v;
}

#define XB_TMO      128
#define XB_XCNT(j)  (256  + 64 * (j))
#define XB_XSUB(j)  (1280 + 64 * (j))
#define XB_XGEN(j)  (2304 + 64 * (j))
#define XB_TOP      3328
#define XB_TOPGEN   3392
#define XCD_BAR_WORDS 3456
#define XB_SPIN_CAP (1u << 18)

__device__ __forceinline__ unsigned xb_ld(unsigned* p)              { return __hip_atomic_load(p, __ATOMIC_RELAXED, __HIP_MEMORY_SCOPE_AGENT); }
__device__ __forceinline__ unsigned xb_add(unsigned* p, unsigned v) { return __hip_atomic_fetch_add(p, v, __ATOMIC_RELAXED, __HIP_MEMORY_SCOPE_AGENT); }
__device__ __forceinline__ unsigned xb_xcc_id() { return (unsigned)__builtin_amdgcn_s_getreg((3 << 11) | 20) & 0xFu; }
#define XB_SPIN(cond, bar) do { unsigned _sp = 0; while (cond) { __builtin_amdgcn_s_sleep(1); \
    if ((++_sp & 255u) == 0u) { if (xb_ld(&(bar)[XB_TMO])) break; if (_sp > XB_SPIN_CAP) { atomicAdd(&(bar)[XB_TMO], 1u); break; } } } } while (0)

struct XcdBarrier {
    unsigned* bar; unsigned x;
    volatile LAS unsigned* st;
};

__device__ __forceinline__ XcdBarrier xcd_barrier_post(unsigned* bar, volatile LAS unsigned* st) {
    XcdBarrier b; b.bar = bar; b.x = xb_xcc_id(); b.st = st;
    if (threadIdx.x == 0) (void)xb_add(&bar[XB_XCNT(b.x)], 1u);
    return b;
}
__device__ __forceinline__ void xcd_barrier_complete(unsigned* bar, unsigned x, unsigned& nloc, unsigned& nx) {
    const unsigned G = gridDim.x * gridDim.y * gridDim.z;
    unsigned sum, cnt, mine, sp = 0u;
    for (;;) {
        sum = 0u; cnt = 0u; mine = 0u;
#pragma unroll
        for (unsigned j = 0; j < 16; ++j) { const unsigned c = xb_ld(&bar[XB_XCNT(j)]); sum += c; cnt += (c > 0u) ? 1u : 0u; mine = (j == x) ? c : mine; }
        if (sum == G) break;
        __builtin_amdgcn_s_sleep(1);
        if ((++sp & 255u) == 0u) { if (xb_ld(&bar[XB_TMO])) break; if (sp > XB_SPIN_CAP) { atomicAdd(&bar[XB_TMO], 1u); break; } }
    }
    nloc = mine > 0u ? mine : 1u; nx = cnt > 0u ? cnt : 1u;
}

__device__ __forceinline__ void xcd_barrier(const XcdBarrier& b) {
    asm volatile("s_waitcnt vmcnt(0)" ::: "memory");
    __syncthreads();
    if (threadIdx.x == 0) {
        unsigned* bar = b.bar;
        __builtin_amdgcn_s_waitcnt(0);
        unsigned nloc = b.st[0], nx = b.st[1];
        if (nloc == 0u) { xcd_barrier_complete(bar, b.x, nloc, nx); b.st[0] = nloc; b.st[1] = nx; }
        const unsigned old = xb_add(&bar[XB_XSUB(b.x)], 1u);
        const unsigned gen = old / nloc;
        if (old + 1u == (gen + 1u) * nloc) {
            __builtin_amdgcn_fence(__ATOMIC_RELEASE, "agent");
            asm volatile("s_waitcnt vmcnt(0)" ::: "memory");
            const unsigned og = xb_add(&bar[XB_TOP], 1u);
            const unsigned tg = og / nx;
            if (og + 1u == (tg + 1u) * nx) xb_add(&bar[XB_TOPGEN], 1u);
            else XB_SPIN(xb_ld(&bar[XB_TOPGEN]) == tg, bar);
            __builtin_amdgcn_fence(__ATOMIC_ACQUIRE, "agent");
            xb_add(&bar[XB_XGEN(b.x)], 1u);
            asm volatile("s_waitcnt vmcnt(0)" ::: "memory");
        } else {
            XB_SPIN(xb_ld(&bar[XB_XGEN(b.x)]) == gen, bar);
            __builtin_amdgcn_fence(__ATOMIC_ACQUIRE, "agent");
            asm volatile("s_waitcnt vmcnt(0)" ::: "memory");
        }
    }
    __syncthreads();
}
struct Frame {
    LAS unsigned char* lds;
    volatile LAS unsigned* MISC;
    gu32* ctl;
    int tid, lane, wave;
    int vcu, G;
    const float* const* in; float* out; unsigned char* ws;
};
#define WSP(T, off) ((T*)(F.ws + (off)))

struct DenseSrc : pg8::StaticOrder {
    const char* A; const char* B; size_t tstepA, tstepB;
    __device__ __forceinline__ void set(const void* A_, const void* B_, int M_, int N_, int K_, int G_, int c_) { init(M_, N_, G_, c_); A = (const char*)A_; B = (const char*)B_; tstepA = (size_t)256 * K_ * 2; tstepB = (size_t)256 * K_ * 2; }
    __device__ __forceinline__ const char* abase(const pg8::Unit& u) const { return A + (size_t)u.pm * tstepA; }
    __device__ __forceinline__ const char* bbase(const pg8::Unit& u) const { return B + (size_t)u.pn * tstepB; }
    __device__ __forceinline__ void aoff(const pg8::Unit&, int K, const int (&R)[2], const int (&C)[2], unsigned (&off)[2][2]) const {
#pragma unroll
        for (int h = 0; h < 2; ++h)
#pragma unroll
            for (int i = 0; i < 2; ++i) off[h][i] = (unsigned)((128 * h + R[i]) * K + C[i]) * 2u;
    }
};

using pg8::f32x4; using pg8::Unit;
struct EpiUT {
    static constexpr bool PERM = false;
    bf16* UT; const float* rstd;
    __device__ __forceinline__ void operator()(const f32x4 (&acc)[2][2][4][2], const Unit& u, int wr, int wc, int fr, int fq) const {
#pragma unroll
        for (int ai = 0; ai < 2; ++ai)
#pragma unroll
            for (int m = 0; m < 4; ++m) {
                const int tok0 = u.pm * 256 + ai * 128 + wr * 64 + m * 16 + 4 * fq;
                const f32x4 rs = *(const f32x4*)(rstd + tok0);
#pragma unroll
                for (int bj = 0; bj < 2; ++bj)
#pragma unroll
                    for (int n = 0; n < 2; ++n) {
                        const int col = u.pn * 256 + bj * 128 + wc * 32 + n * 16 + fr;
                        const f32x4 v = acc[ai][bj][m][n] * rs;
                        v2u w; w.x = pg8::cvt_pk_bf16(v[0], v[1]); w.y = pg8::cvt_pk_bf16(v[2], v[3]);
                        *(v2u*)(UT + (size_t)col * M + tok0) = w; }
            }
    }
};
struct EpiQK {
    static constexpr bool PERM = true;
    bf16* Q; bf16* Kp; const float* rstd;
    __device__ __forceinline__ void operator()(const f32x4 (&acc)[2][2][4][2], const Unit& u, int wr, int wc, int fr, int fq) const {
        const int row0 = u.pm * 256 + wr * 64 + fr; const int t = u.pn >> 1; bf16* base = t ? Kp : Q; const float sc = t ? 1.f : 0.125f;
        const int col0 = (u.pn & 1) * 256 + wc * 32 + 8 * fq;
#pragma unroll
        for (int ai = 0; ai < 2; ++ai)
#pragma unroll
            for (int m = 0; m < 4; ++m) { const int row = row0 + ai * 128 + m * 16; const float r = rstd[row] * sc; bf16* rowp = base + (size_t)row * 512 + col0;
#pragma unroll
                for (int bj = 0; bj < 2; ++bj) { const f32x4 v0 = acc[ai][bj][m][0] * r, v1 = acc[ai][bj][m][1] * r;
                    v4u w; w.x = pg8::cvt_pk_bf16(v0[0], v0[1]); w.y = pg8::cvt_pk_bf16(v0[2], v0[3]); w.z = pg8::cvt_pk_bf16(v1[0], v1[1]); w.w = pg8::cvt_pk_bf16(v1[2], v1[3]);
                    *(v4u*)(rowp + bj * 128) = w; } }
    }
};
struct EpiH1 {
    static constexpr bool PERM = true;
    bf16* H1; const float* x;
    __device__ __forceinline__ void operator()(const f32x4 (&acc)[2][2][4][2], const Unit& u, int wr, int wc, int fr, int fq) const {
        const int row0 = u.pm * 256 + wr * 64 + fr; const int col0 = u.pn * 256 + wc * 32 + 8 * fq;
#pragma unroll
        for (int ai = 0; ai < 2; ++ai)
#pragma unroll
            for (int m = 0; m < 4; ++m) { const size_t ro = (size_t)(row0 + ai * 128 + m * 16) * DM + col0;
#pragma unroll
                for (int bj = 0; bj < 2; ++bj) { const f32x4 x0 = *(const f32x4*)(x + ro + bj * 128), x1 = *(const f32x4*)(x + ro + bj * 128 + 4);
                    const f32x4 v0 = acc[ai][bj][m][0] + x0, v1 = acc[ai][bj][m][1] + x1;
                    v4u w; w.x = pg8::cvt_pk_bf16(v0[0], v0[1]); w.y = pg8::cvt_pk_bf16(v0[2], v0[3]); w.z = pg8::cvt_pk_bf16(v1[0], v1[1]); w.w = pg8::cvt_pk_bf16(v1[2], v1[3]);
                    *(v4u*)(H1 + ro + bj * 128) = w; } }
    }
};
struct EpiPL {
    static constexpr bool PERM = true;
    bf16* PL;
    __device__ __forceinline__ void operator()(const f32x4 (&acc)[2][2][4][2], const Unit& u, int wr, int wc, int fr, int fq) const {
        const int row0 = u.pm * 256 + wr * 64 + fr; const int col0 = u.pn * 256 + wc * 32 + 8 * fq;
#pragma unroll
        for (int ai = 0; ai < 2; ++ai)
#pragma unroll
            for (int m = 0; m < 4; ++m) { const size_t ro = (size_t)(row0 + ai * 128 + m * 16) * DM + col0;
#pragma unroll
                for (int bj = 0; bj < 2; ++bj) { const f32x4 v0 = acc[ai][bj][m][0], v1 = acc[ai][bj][m][1];
                    v4u w; w.x = pg8::cvt_pk_bf16(v0[0], v0[1]); w.y = pg8::cvt_pk_bf16(v0[2], v0[3]); w.z = pg8::cvt_pk_bf16(v1[0], v1[1]); w.w = pg8::cvt_pk_bf16(v1[2], v1[3]);
                    *(v4u*)(PL + ro + bj * 128) = w; } }
    }
};
__device__ __forceinline__ float sigmoidf_(float v) { return 1.f / (1.f + __expf(-v)); }
struct EpiPLE {
    static constexpr bool PERM = true;
    bf16* H3; const bf16* H2; const bf16* PL; const float* rstd;
    __device__ __forceinline__ void operator()(const f32x4 (&acc)[2][2][4][2], const Unit& u, int wr, int wc, int fr, int fq) const {
        const int row0 = u.pm * 256 + wr * 64 + fr; const int col0 = u.pn * 256 + wc * 32 + 8 * fq;
#pragma unroll
        for (int ai = 0; ai < 2; ++ai)
#pragma unroll
            for (int m = 0; m < 4; ++m) { const int row = row0 + ai * 128 + m * 16; const size_t ro = (size_t)row * DM + col0; const float r = rstd[row];
#pragma unroll
                for (int bj = 0; bj < 2; ++bj) { const v4u h = *(const v4u*)(H2 + ro + bj * 128), p = *(const v4u*)(PL + ro + bj * 128);
                    const f32x4 a0 = acc[ai][bj][m][0] * r, a1 = acc[ai][bj][m][1] * r;
                    float o[8];
                    o[0] = bflo(h.x) + bflo(p.x) * sigmoidf_(a0[0]); o[1] = bfhi(h.x) + bfhi(p.x) * sigmoidf_(a0[1]);
                    o[2] = bflo(h.y) + bflo(p.y) * sigmoidf_(a0[2]); o[3] = bfhi(h.y) + bfhi(p.y) * sigmoidf_(a0[3]);
                    o[4] = bflo(h.z) + bflo(p.z) * sigmoidf_(a1[0]); o[5] = bfhi(h.z) + bfhi(p.z) * sigmoidf_(a1[1]);
                    o[6] = bflo(h.w) + bflo(p.w) * sigmoidf_(a1[2]); o[7] = bfhi(h.w) + bfhi(p.w) * sigmoidf_(a1[3]);
                    v4u w; w.x = pg8::cvt_pk_bf16(o[0], o[1]); w.y = pg8::cvt_pk_bf16(o[2], o[3]); w.z = pg8::cvt_pk_bf16(o[4], o[5]); w.w = pg8::cvt_pk_bf16(o[6], o[7]);
                    *(v4u*)(H3 + ro + bj * 128) = w; } }
    }
};

template <class GainF, class RowF>
__device__ __forceinline__ void p0_transpose_item(const float* W, int N, bf16* WT, int ldk, LAS float* scr, int item, int lane, GainF gain, RowF rowmap) {
    const int nblk = N / 32, kb = item / nblk, nb = item % nblk, k0 = 64 * kb, n0 = 32 * nb;
#pragma unroll 8
    for (int i = 0; i < 32; ++i) { const int kk = 2 * i + (lane >> 5); scr[kk * 33 + (lane & 31)] = W[(size_t)(k0 + kk) * N + n0 + (lane & 31)] * gain(k0 + kk); }
    LDS_WAIT(); asm volatile("" ::: "memory");
    const int c = lane & 7;
#pragma unroll
    for (int j = 0; j < 4; ++j) { const int n = (lane >> 3) + 8 * j; const LAS float* s = scr + (8 * c) * 33 + n;
        v4u o; o.x = pk2(s[0 * 33], s[1 * 33]); o.y = pk2(s[2 * 33], s[3 * 33]); o.z = pk2(s[4 * 33], s[5 * 33]); o.w = pk2(s[6 * 33], s[7 * 33]);
        *(GAS v4u*)(WT + (size_t)rowmap(n0 + n) * ldk + k0 + 8 * c) = o; }
    LDS_WAIT(); asm volatile("" ::: "memory");
}
__device__ __forceinline__ void p0_filter_task(Frame& F, int task) {
    const int lane = F.lane, n0 = task * 4;
    const float* w1 = F.in[6]; const float* b1 = F.in[7]; const float* f1 = F.in[8]; const float* w2 = F.in[9]; const float* b2 = F.in[10]; const float* f2 = F.in[11]; const float* w3 = F.in[12];
    bf16* HYK = WSP(bf16, WS_HYK);
    float h2[4];
#pragma unroll
    for (int p = 0; p < 4; ++p) {
        const int n = n0 + p; const float t = (float)n * (1.0f / 2047.0f); const float w = 6.283185307179586f * (float)n * (1.0f / 2048.0f);
        float z = 0.f;
        if (lane == 0) z = t;
        else if (lane <= 16) { const float band = 1e-4f + (float)(lane - 1) * ((15.0f - 1e-4f) / 15.0f); z = cosf(band * w); }
        else if (lane <= 32) { const float band = 1e-4f + (float)(lane - 17) * ((15.0f - 1e-4f) / 15.0f); z = -sinf(band * w); }
        float a = b1[lane];
#pragma unroll
        for (int i = 0; i < 33; ++i) a += __shfl(z, i) * w1[i * 64 + lane];
        const float h1 = sinf(f1[lane] * a);
        float a2 = b2[lane];
#pragma unroll 16
        for (int j = 0; j < 64; ++j) a2 += __shfl(h1, j) * w2[j * 64 + lane];
        h2[p] = sinf(f2[lane] * a2);
    }
#pragma nounroll
    for (int qt = 0; qt < 4; ++qt) {
        float acc[8][4];
#pragma unroll
        for (int i = 0; i < 8; ++i)
#pragma unroll
            for (int p = 0; p < 4; ++p) acc[i][p] = 0.f;
#pragma nounroll
        for (int j = 0; j < 64; ++j) {
            float hj[4];
#pragma unroll
            for (int p = 0; p < 4; ++p) hj[p] = __shfl(h2[p], j);
#pragma unroll
            for (int i = 0; i < 8; ++i) { const float wv = w3[(size_t)j * 2048 + (qt * 8 + i) * 64 + lane];
#pragma unroll
                for (int p = 0; p < 4; ++p) acc[i][p] += hj[p] * wv; }
        }
#pragma unroll
        for (int i = 0; i < 8; ++i) {
            const int col = (qt * 8 + i) * 64 + lane, dir = col >> 10, o = (col >> 9) & 1, c = col & 511;
            const float dl = 3.0701134573253944f + (float)c * ((15.350567286626972f - 3.0701134573253944f) / 511.0f);
#pragma unroll
            for (int p = 0; p < 4; ++p) { const int n = n0 + p; const float t = (float)n * (1.0f / 2047.0f);
                const float val = acc[i][p] * expf(-t * dl);
                const int q = dir ? 2048 + n : 2048 - n;
                if (!(dir == 1 && n == 0)) HYK[(size_t)(o * 512 + c) * GSTR + q] = (bf16)f2bf(val); }
        }
    }
}
__device__ __forceinline__ void p0_prologue(Frame& F) {
    LAS float* scr = (LAS float*)(F.lds + RING_OFF + F.wave * 16384);
    const int gw = F.vcu * NWAVES + F.wave, NGW = F.G * NWAVES, lane = F.lane;
    for (int task = gw; task < 512; task += NGW) p0_filter_task(F, task);
    { bf16* HYK = WSP(bf16, WS_HYK);
      for (int i = blockIdx.x * 512 + F.tid; i < 1024 * 9; i += F.G * 512) { const int row = i / 9, j = i % 9; HYK[(size_t)row * GSTR + (j == 0 ? 0 : 4095 + j)] = 0; } }
    {
        const float* g_mix = F.in[2]; const float* g_ohy = F.in[15]; const float* g_ona = F.in[16]; const float* g_ffn = F.in[18]; const float* g_ple = F.in[26];
        constexpr int I_IN = 16 * 96, I_OUT = 16 * 32, I_G = 16 * 32, I_P = 4 * 32, I_E1 = 16 * 16, I_E2 = 8 * 32;
        constexpr int NITEMS = I_IN + I_OUT + I_G + I_P + NE * (2 * I_E1 + I_E2);
        for (int it = gw; it < NITEMS; it += NGW) {
            int r = it;
            if (r < I_IN) { p0_transpose_item(F.in[3], 3072, WSP(bf16, WS_WIN), DM, scr, r, lane, [&](int k) { return g_mix[k]; },
                                              [](int n) { return n < 1536 ? n : (n < 2560 ? n + 512 : n - 1024); }); continue; } r -= I_IN;
            if (r < I_OUT) { p0_transpose_item(F.in[17], 1024, WSP(bf16, WS_WOUT), DM, scr, r, lane, [&](int k) { return k < 512 ? g_ohy[k] : g_ona[k - 512]; }, [](int n) { return n; }); continue; } r -= I_OUT;
            if (r < I_G) { p0_transpose_item(F.in[27], 1024, WSP(bf16, WS_WG), DM, scr, r, lane, [&](int k) { return g_ple[k]; }, [](int n) { return n; }); continue; } r -= I_G;
            if (r < I_P) { p0_transpose_item(F.in[28], 1024, WSP(bf16, WS_WP), PLE, scr, r, lane, [](int) { return 1.0f; }, [](int n) { return n; }); continue; } r -= I_P;
            const int e = r / (2 * I_E1 + I_E2); r -= e * (2 * I_E1 + I_E2);
            if (r < I_E1) { p0_transpose_item(F.in[23] + (size_t)e * DM * DE, DE, WSP(bf16, WS_W13) + (size_t)e * 1024 * DM, DM, scr, r, lane, [&](int k) { return g_ffn[k]; }, [](int n) { return (n >> 2) * 8 + (n & 3); }); continue; } r -= I_E1;
            if (r < I_E1) { p0_transpose_item(F.in[24] + (size_t)e * DM * DE, DE, WSP(bf16, WS_W13) + (size_t)e * 1024 * DM, DM, scr, r, lane, [&](int k) { return g_ffn[k]; }, [](int n) { return (n >> 2) * 8 + (n & 3) + 4; }); continue; } r -= I_E1;
            p0_transpose_item(F.in[25] + (size_t)e * DE * DM, DM, WSP(bf16, WS_W2) + (size_t)e * DM * DE, DE, scr, r, lane, [](int) { return 1.0f; }, [](int n) { return n; });
        }
        float* WR = WSP(float, WS_WR);
        for (int i = blockIdx.x * 512 + F.tid; i < 36 * 1024; i += F.G * 512) { const int j = i >> 10, k = i & 1023;
            WR[i] = (j < 4 ? F.in[19][k * 4 + j] : F.in[21][k * 32 + (j - 4)]) * g_ffn[k]; }
    }
    {
        const float* x = F.in[0]; bf16* XB = WSP(bf16, WS_XB); float* rsx = WSP(float, WS_RSX);
        for (int m = gw; m < M; m += NGW) {
            const GAS f32x4* xr = (const GAS f32x4*)(x + (size_t)m * DM) + lane;
            f32x4 v[4]; float s = 0.f;
#pragma unroll
            for (int j = 0; j < 4; ++j) { v[j] = xr[64 * j]; s += (v[j].x * v[j].x + v[j].y * v[j].y) + (v[j].z * v[j].z + v[j].w * v[j].w); }
            s = wave_sum(s);
            if (lane == 0) rsx[m] = rsqrtf(s * (1.0f / DM) + EPS);
            GAS v2u* o8 = (GAS v2u*)(XB + (size_t)m * DM) + lane;
#pragma unroll
            for (int j = 0; j < 4; ++j) { v2u w; w.x = pk2(v[j].x, v[j].y); w.y = pk2(v[j].z, v[j].w); o8[64 * j] = w; }
        }
        const float* p = F.in[1]; bf16* PB = WSP(bf16, WS_PB);
        for (int m = gw; m < M; m += NGW) {
            const f32x4 v = ((const GAS f32x4*)(p + (size_t)m * PLE))[lane];
            v2u w; w.x = pk2(v.x, v.y); w.y = pk2(v.z, v.w); ((GAS v2u*)(PB + (size_t)m * PLE))[lane] = w;
        }
    }
}

__device__ __forceinline__ float sc3(const bf16* u, int s, float w0, float w1, float w2, float cb) {
    const float um = s > 0 ? bf2f(u[s - 1]) : 0.f, u0 = bf2f(u[s]), up = s < SEQ - 1 ? bf2f(u[s + 1]) : 0.f;
    return cb + w0 * um + w1 * u0 + w2 * up;
}
__device__ __forceinline__ void hyena_naive(Frame& F) {
    LAS float* Gl = (LAS float*)F.lds; LAS float* z = Gl + 4112;
    const bf16* UT = WSP(bf16, WS_UT); const bf16* HYK = WSP(bf16, WS_HYK); bf16* YT = WSP(bf16, WS_YT);
    const float* cw = F.in[4]; const float* cbv = F.in[5]; const float* skip = F.in[13];
    const int tid = F.tid;
    for (int unit = blockIdx.x; unit < HYW * NB; unit += F.G) {
        const int c = unit / NB, b = unit % NB;
        const bf16* ux1 = UT + (size_t)c * M + b * SEQ; const bf16* ux2 = UT + (size_t)(512 + c) * M + b * SEQ; const bf16* uv = UT + (size_t)(1024 + c) * M + b * SEQ;
        __syncthreads();
        for (int s = tid; s < SEQ; s += 512) z[s] = bfr(sc3(uv, s, cw[1024 + c], cw[1536 + 1024 + c], cw[3072 + 1024 + c], cbv[1024 + c]));
        for (int o = 0; o < 2; ++o) {
            for (int q = tid; q < GSTR; q += 512) Gl[q] = bf2f(HYK[(size_t)(o * 512 + c) * GSTR + q]);
            __syncthreads();
            const int t4 = tid * 4; float acc[4] = {0.f, 0.f, 0.f, 0.f};
            for (int s = 0; s < SEQ; ++s) { const float zs = z[s];
#pragma unroll
                for (int j = 0; j < 4; ++j) acc[j] += Gl[2048 - (t4 + j) + s] * zs; }
            const bf16* ug = o ? ux2 : ux1; const int gc = o ? 512 + c : c; const float sk = skip[o * 512 + c];
            float outv[4];
#pragma unroll
            for (int j = 0; j < 4; ++j) { const float g = sc3(ug, t4 + j, cw[gc], cw[1536 + gc], cw[3072 + gc], cbv[gc]); outv[j] = g * (acc[j] + z[t4 + j] * sk); }
            __syncthreads();
            if (o == 0) {
#pragma unroll
                for (int j = 0; j < 4; ++j) z[t4 + j] = bfr(outv[j]);
            } else {
                v2u w; w.x = pk2(outv[0], outv[1]); w.y = pk2(outv[2], outv[3]); *(v2u*)(YT + (size_t)c * M + b * SEQ + t4) = w;
            }
            __syncthreads();
        }
    }
}
__device__ __forceinline__ void natten_naive(Frame& F) {
    const bf16* Q = WSP(bf16, WS_Q); const bf16* Kb = WSP(bf16, WS_K); const bf16* VT = WSP(bf16, WS_UT) + (size_t)1536 * M; bf16* YNA = WSP(bf16, WS_YNA);
    const float* rpb = F.in[14];
    for (int unit = blockIdx.x; unit < M / 64; unit += F.G) {
        const int b = unit >> 5, r = unit & 31, h = F.tid >> 6, qc = F.tid & 63;
        const int tok = b * SEQ + r * 64 + qc;
        float q[64], o[64];
#pragma unroll
        for (int d8 = 0; d8 < 8; ++d8) { const v4u w = *(const v4u*)(Q + (size_t)tok * 512 + h * 64 + d8 * 8);
            q[d8 * 8 + 0] = bflo(w.x); q[d8 * 8 + 1] = bfhi(w.x); q[d8 * 8 + 2] = bflo(w.y); q[d8 * 8 + 3] = bfhi(w.y); q[d8 * 8 + 4] = bflo(w.z); q[d8 * 8 + 5] = bfhi(w.z); q[d8 * 8 + 6] = bflo(w.w); q[d8 * 8 + 7] = bfhi(w.w); }
#pragma unroll
        for (int d = 0; d < 64; ++d) o[d] = 0.f;
        const int rs0 = min(max(r - 4, 0), 24), cs0 = min(max(qc - 8, 0), 48);
        float mx = -1e30f, l = 0.f;
        for (int kk = 0; kk < 128; ++kk) {
            const int krow = rs0 + (kk >> 4), kcol = cs0 + (kk & 15), kt = b * SEQ + krow * 64 + kcol;
            float s = 0.f;
#pragma unroll
            for (int d8 = 0; d8 < 8; ++d8) { const v4u w = *(const v4u*)(Kb + (size_t)kt * 512 + h * 64 + d8 * 8);
                s += q[d8 * 8 + 0] * bflo(w.x) + q[d8 * 8 + 1] * bfhi(w.x) + q[d8 * 8 + 2] * bflo(w.y) + q[d8 * 8 + 3] * bfhi(w.y) + q[d8 * 8 + 4] * bflo(w.z) + q[d8 * 8 + 5] * bfhi(w.z) + q[d8 * 8 + 6] * bflo(w.w) + q[d8 * 8 + 7] * bfhi(w.w); }
            s += rpb[(h * 15 + (krow - r + 7)) * 31 + (kcol - qc + 15)];
            const float mn = fmaxf(mx, s), scl = __expf(mx - mn), p = __expf(s - mn);
            l = l * scl + p; mx = mn;
#pragma unroll
            for (int d = 0; d < 64; ++d) o[d] = o[d] * scl + p * bf2f(VT[(size_t)(h * 64 + d) * M + kt]);
        }
        const float inv = 1.f / l;
#pragma unroll
        for (int d8 = 0; d8 < 8; ++d8) { v4u w; w.x = pk2(o[d8 * 8] * inv, o[d8 * 8 + 1] * inv); w.y = pk2(o[d8 * 8 + 2] * inv, o[d8 * 8 + 3] * inv); w.z = pk2(o[d8 * 8 + 4] * inv, o[d8 * 8 + 5] * inv); w.w = pk2(o[d8 * 8 + 6] * inv, o[d8 * 8 + 7] * inv);
            *(v4u*)(YNA + (size_t)tok * 512 + h * 64 + d8 * 8) = w; }
    }
}

__device__ __forceinline__ void mixnorm(Frame& F) {
    LAS bf16* T = (LAS bf16*)F.lds; constexpr int TP = 520;
    const bf16* YT = WSP(bf16, WS_YT); const bf16* YNA = WSP(bf16, WS_YNA); bf16* MIX = WSP(bf16, WS_MIX);
    const int tid = F.tid, lane = F.lane, wave = F.wave;
    for (int unit = blockIdx.x; unit < M / 64; unit += F.G) {
        const int tok0 = unit * 64;
        __syncthreads();
#pragma unroll
        for (int it = 0; it < 8; ++it) { const int idx = it * 512 + tid, c = idx >> 3, tg = idx & 7;
            const v4u w = *(const v4u*)(YT + (size_t)c * M + tok0 + tg * 8);
            LAS bf16* d = T + (tg * 8) * TP + c;
            d[0 * TP] = (bf16)(w.x & 0xffff); d[1 * TP] = (bf16)(w.x >> 16); d[2 * TP] = (bf16)(w.y & 0xffff); d[3 * TP] = (bf16)(w.y >> 16);
            d[4 * TP] = (bf16)(w.z & 0xffff); d[5 * TP] = (bf16)(w.z >> 16); d[6 * TP] = (bf16)(w.w & 0xffff); d[7 * TP] = (bf16)(w.w >> 16); }
        __syncthreads();
#pragma unroll
        for (int i = 0; i < 8; ++i) { const int tl = wave * 8 + i, tok = tok0 + tl;
            {   const v4u w = *(const LAS v4u*)(T + tl * TP + lane * 8);
                float v[8] = {bflo(w.x), bfhi(w.x), bflo(w.y), bfhi(w.y), bflo(w.z), bfhi(w.z), bflo(w.w), bfhi(w.w)}; float s = 0.f;
#pragma unroll
                for (int j = 0; j < 8; ++j) s += v[j] * v[j];
                const float r = rsqrtf(wave_sum(s) * (1.0f / HYW) + EPS);
                v4u o; o.x = pk2(v[0] * r, v[1] * r); o.y = pk2(v[2] * r, v[3] * r); o.z = pk2(v[4] * r, v[5] * r); o.w = pk2(v[6] * r, v[7] * r);
                *(v4u*)(MIX + (size_t)tok * DM + lane * 8) = o; }
            {   const v4u w = *(const v4u*)(YNA + (size_t)tok * 512 + lane * 8);
                float v[8] = {bflo(w.x), bfhi(w.x), bflo(w.y), bfhi(w.y), bflo(w.z), bfhi(w.z), bflo(w.w), bfhi(w.w)}; float s = 0.f;
#pragma unroll
                for (int j = 0; j < 8; ++j) s += v[j] * v[j];
                const float r = rsqrtf(wave_sum(s) * (1.0f / NAW) + EPS);
                v4u o; o.x = pk2(v[0] * r, v[1] * r); o.y = pk2(v[2] * r, v[3] * r); o.z = pk2(v[4] * r, v[5] * r); o.w = pk2(v[6] * r, v[7] * r);
                *(v4u*)(MIX + (size_t)tok * DM + 512 + lane * 8) = o; }
        }
    }
}

__device__ __forceinline__ void router_naive(Frame& F) {
    const bf16* H1 = WSP(bf16, WS_H1); const float* WR = WSP(float, WS_WR); float* rs1 = WSP(float, WS_RS1); float* GATE = WSP(float, WS_GATE); int* LIST = WSP(int, WS_LIST);
    const float* bg = F.in[20]; const float* be = F.in[22];
    const int gw = F.vcu * NWAVES + F.wave, NGW = F.G * NWAVES, lane = F.lane;
    for (int tok = gw; tok < M; tok += NGW) {
        const v4u wa = *(const v4u*)(H1 + (size_t)tok * DM + lane * 8), wb = *(const v4u*)(H1 + (size_t)tok * DM + 512 + lane * 8);
        float xv[16] = {bflo(wa.x), bfhi(wa.x), bflo(wa.y), bfhi(wa.y), bflo(wa.z), bfhi(wa.z), bflo(wa.w), bfhi(wa.w), bflo(wb.x), bfhi(wb.x), bflo(wb.y), bfhi(wb.y), bflo(wb.z), bfhi(wb.z), bflo(wb.w), bfhi(wb.w)};
        float ss = 0.f;
#pragma unroll
        for (int i = 0; i < 16; ++i) ss += xv[i] * xv[i];
        const float rstd = rsqrtf(wave_sum(ss) * (1.0f / DM) + EPS);
        if (lane == 0) rs1[tok] = rstd;
        float mylg = 0.f;
#pragma nounroll
        for (int j = 0; j < 36; ++j) {
            const f32x4 w0 = *(const f32x4*)(WR + j * 1024 + lane * 8), w1 = *(const f32x4*)(WR + j * 1024 + lane * 8 + 4), w2 = *(const f32x4*)(WR + j * 1024 + 512 + lane * 8), w3 = *(const f32x4*)(WR + j * 1024 + 512 + lane * 8 + 4);
            float a = xv[0] * w0[0] + xv[1] * w0[1] + xv[2] * w0[2] + xv[3] * w0[3] + xv[4] * w1[0] + xv[5] * w1[1] + xv[6] * w1[2] + xv[7] * w1[3]
                    + xv[8] * w2[0] + xv[9] * w2[1] + xv[10] * w2[2] + xv[11] * w2[3] + xv[12] * w3[0] + xv[13] * w3[1] + xv[14] * w3[2] + xv[15] * w3[3];
            const float sm = wave_sum(a) * rstd + (j < 4 ? bg[j] : be[j - 4]);
            if (lane == j) mylg = sm;
        }
        float lg[4];
#pragma unroll
        for (int j = 0; j < 4; ++j) lg[j] = __shfl(mylg, j);
        int g = 0; float gm = lg[0];
#pragma unroll
        for (int j = 1; j < 4; ++j) if (lg[j] > gm) { gm = lg[j]; g = j; }
        float gz = 0.f;
#pragma unroll
        for (int j = 0; j < 4; ++j) gz += __expf(lg[j] - gm);
        const float g_w = 1.f / gz;
        float e8[8];
#pragma unroll
        for (int i = 0; i < 8; ++i) e8[i] = __shfl(mylg, 4 + g * 8 + i);
        int i0 = 0; float m0 = e8[0];
#pragma unroll
        for (int i = 1; i < 8; ++i) if (e8[i] > m0) { m0 = e8[i]; i0 = i; }
        int i1 = -1; float m1 = -3.0e38f;
#pragma unroll
        for (int i = 0; i < 8; ++i) if (i != i0 && e8[i] > m1) { m1 = e8[i]; i1 = i; }
        const float r = __expf(m1 - m0); const float gate0 = g_w / (1.f + r), gate1 = g_w * r / (1.f + r);
        if (lane == 0) {
            const int e0 = g * 8 + i0, e1 = g * 8 + i1;
            const unsigned s0 = atomicAdd((unsigned*)(F.ctl + CW_CNT + 64 * e0), 1u); LIST[(size_t)e0 * LCAP + s0] = tok * 2; GATE[tok * 2] = gate0;
            const unsigned s1 = atomicAdd((unsigned*)(F.ctl + CW_CNT + 64 * e1), 1u); LIST[(size_t)e1 * LCAP + s1] = tok * 2 + 1; GATE[tok * 2 + 1] = gate1;
        }
    }
}

__device__ __forceinline__ float siluf_(float v) { return v / (1.f + __expf(-v)); }
__device__ __forceinline__ void moe_naive(Frame& F) {
    LAS int* tab = (LAS int*)(F.lds + TAB_OFF);
    LAS float* xs = (LAS float*)F.lds;
    LAS float* hs = xs + 8 * 1024;
    LAS int* tk = (LAS int*)(hs + 8 * 512);
    const bf16* H1 = WSP(bf16, WS_H1); const float* rs1 = WSP(float, WS_RS1); const float* GATE = WSP(float, WS_GATE); const int* LIST = WSP(int, WS_LIST);
    const bf16* W13 = WSP(bf16, WS_W13); const bf16* W2 = WSP(bf16, WS_W2); bf16* YK0 = WSP(bf16, WS_YK0); bf16* YK1 = WSP(bf16, WS_YK1);
    const int tid = F.tid;
    __syncthreads();
    if (tid < NE) tab[40 + tid] = (int)__hip_atomic_load(F.ctl + CW_CNT + 64 * tid, RLX_AGENT);
    __syncthreads();
    if (tid == 0) { int s = 0; for (int e = 0; e < NE; ++e) { tab[e] = s; s += (tab[40 + e] + 7) >> 3; } tab[NE] = s; }
    __syncthreads();
    const int total = tab[NE];
    for (int unit = blockIdx.x; unit < total; unit += F.G) {
        int e = 0;
        for (int j = 1; j < NE; ++j) if (tab[j] <= unit) e = j;
        const int ch = unit - tab[e], ne = tab[40 + e];
        __syncthreads();
        if (tid < 8) { const int idx = ch * 8 + tid; tk[tid] = idx < ne ? LIST[(size_t)e * LCAP + idx] : -1; }
        __syncthreads();
        for (int i = tid; i < 8 * 1024; i += 512) { const int r = i >> 10, k = i & 1023; const int t = tk[r]; xs[i] = t >= 0 ? bf2f(H1[(size_t)(t >> 1) * DM + k]) : 0.f; }
        __syncthreads();
        {
            const int c1 = (tid >> 2) * 8 + (tid & 3);
            const bf16* w1r = W13 + ((size_t)e * 1024 + c1) * DM; const bf16* w3r = w1r + 4 * DM;
            float a1[8], a3[8];
#pragma unroll
            for (int r = 0; r < 8; ++r) { a1[r] = 0.f; a3[r] = 0.f; }
            for (int k8 = 0; k8 < 128; ++k8) {
                const v4u u1 = *(const v4u*)(w1r + k8 * 8), u3 = *(const v4u*)(w3r + k8 * 8);
                const float p1[8] = {bflo(u1.x), bfhi(u1.x), bflo(u1.y), bfhi(u1.y), bflo(u1.z), bfhi(u1.z), bflo(u1.w), bfhi(u1.w)};
                const float p3[8] = {bflo(u3.x), bfhi(u3.x), bflo(u3.y), bfhi(u3.y), bflo(u3.z), bfhi(u3.z), bflo(u3.w), bfhi(u3.w)};
#pragma unroll
                for (int r = 0; r < 8; ++r) { const f32x4 xa = *(const LAS f32x4*)(xs + r * 1024 + k8 * 8), xb = *(const LAS f32x4*)(xs + r * 1024 + k8 * 8 + 4);
                    a1[r] += xa[0] * p1[0] + xa[1] * p1[1] + xa[2] * p1[2] + xa[3] * p1[3] + xb[0] * p1[4] + xb[1] * p1[5] + xb[2] * p1[6] + xb[3] * p1[7];
                    a3[r] += xa[0] * p3[0] + xa[1] * p3[1] + xa[2] * p3[2] + xa[3] * p3[3] + xb[0] * p3[4] + xb[1] * p3[5] + xb[2] * p3[6] + xb[3] * p3[7]; }
            }
#pragma unroll
            for (int r = 0; r < 8; ++r) { const int t = tk[r]; const float rs = t >= 0 ? rs1[t >> 1] : 0.f; hs[r * 512 + tid] = bfr(siluf_(a1[r] * rs) * (a3[r] * rs)); }
        }
        __syncthreads();
#pragma unroll
        for (int cc = 0; cc < 2; ++cc) { const int c = tid * 2 + cc; const bf16* w2r = W2 + ((size_t)e * DM + c) * DE;
            float a[8];
#pragma unroll
            for (int r = 0; r < 8; ++r) a[r] = 0.f;
            for (int k8 = 0; k8 < 64; ++k8) { const v4u u = *(const v4u*)(w2r + k8 * 8);
                const float p[8] = {bflo(u.x), bfhi(u.x), bflo(u.y), bfhi(u.y), bflo(u.z), bfhi(u.z), bflo(u.w), bfhi(u.w)};
#pragma unroll
                for (int r = 0; r < 8; ++r) { const f32x4 xa = *(const LAS f32x4*)(hs + r * 512 + k8 * 8), xb = *(const LAS f32x4*)(hs + r * 512 + k8 * 8 + 4);
                    a[r] += xa[0] * p[0] + xa[1] * p[1] + xa[2] * p[2] + xa[3] * p[3] + xb[0] * p[4] + xb[1] * p[5] + xb[2] * p[6] + xb[3] * p[7]; } }
#pragma unroll
            for (int r = 0; r < 8; ++r) { const int t = tk[r]; if (t >= 0) { bf16* Y = (t & 1) ? YK1 : YK0; Y[(size_t)(t >> 1) * DM + c] = (bf16)f2bf(a[r] * GATE[t]); } }
        }
    }
}

__device__ __forceinline__ void combine(Frame& F) {
    const bf16* H1 = WSP(bf16, WS_H1); const bf16* Y0 = WSP(bf16, WS_YK0); const bf16* Y1 = WSP(bf16, WS_YK1); bf16* H2 = WSP(bf16, WS_H2); float* rs2 = WSP(float, WS_RS2);
    const int gw = F.vcu * NWAVES + F.wave, NGW = F.G * NWAVES, lane = F.lane;
    for (int tok = gw; tok < M; tok += NGW) {
        float ss = 0.f;
#pragma unroll
        for (int hh = 0; hh < 2; ++hh) { const size_t o = (size_t)tok * DM + hh * 512 + lane * 8;
            const v4u a = *(const v4u*)(H1 + o), b = *(const v4u*)(Y0 + o), c = *(const v4u*)(Y1 + o);
            float v[8] = {bflo(a.x) + bflo(b.x) + bflo(c.x), bfhi(a.x) + bfhi(b.x) + bfhi(c.x), bflo(a.y) + bflo(b.y) + bflo(c.y), bfhi(a.y) + bfhi(b.y) + bfhi(c.y),
                          bflo(a.z) + bflo(b.z) + bflo(c.z), bfhi(a.z) + bfhi(b.z) + bfhi(c.z), bflo(a.w) + bflo(b.w) + bflo(c.w), bfhi(a.w) + bfhi(b.w) + bfhi(c.w)};
            v4u w; w.x = pk2(v[0], v[1]); w.y = pk2(v[2], v[3]); w.z = pk2(v[4], v[5]); w.w = pk2(v[6], v[7]);
            *(v4u*)(H2 + o) = w;
            const float q[8] = {bflo(w.x), bfhi(w.x), bflo(w.y), bfhi(w.y), bflo(w.z), bfhi(w.z), bflo(w.w), bfhi(w.w)};
#pragma unroll
            for (int j = 0; j < 8; ++j) ss += q[j] * q[j]; }
        ss = wave_sum(ss);
        if (lane == 0) rs2[tok] = rsqrtf(ss * (1.0f / DM) + EPS);
    }
}
__device__ __forceinline__ void final_norm(Frame& F) {
    const bf16* H3 = WSP(bf16, WS_H3); const float* gf = F.in[29]; float* out = F.out;
    const int gw = F.vcu * NWAVES + F.wave, NGW = F.G * NWAVES, lane = F.lane;
    for (int tok = gw; tok < M; tok += NGW) {
        float v[16]; float ss = 0.f;
#pragma unroll
        for (int hh = 0; hh < 2; ++hh) { const v4u a = *(const v4u*)(H3 + (size_t)tok * DM + hh * 512 + lane * 8);
            v[hh * 8 + 0] = bflo(a.x); v[hh * 8 + 1] = bfhi(a.x); v[hh * 8 + 2] = bflo(a.y); v[hh * 8 + 3] = bfhi(a.y); v[hh * 8 + 4] = bflo(a.z); v[hh * 8 + 5] = bfhi(a.z); v[hh * 8 + 6] = bflo(a.w); v[hh * 8 + 7] = bfhi(a.w); }
#pragma unroll
        for (int j = 0; j < 16; ++j) ss += v[j] * v[j];
        const float r = rsqrtf(wave_sum(ss) * (1.0f / DM) + EPS);
#pragma unroll
        for (int hh = 0; hh < 2; ++hh) { const int c0 = hh * 512 + lane * 8; const f32x4 g0 = *(const f32x4*)(gf + c0), g1 = *(const f32x4*)(gf + c0 + 4);
            f32x4 o0 = {v[hh * 8 + 0] * r * g0[0], v[hh * 8 + 1] * r * g0[1], v[hh * 8 + 2] * r * g0[2], v[hh * 8 + 3] * r * g0[3]};
            f32x4 o1 = {v[hh * 8 + 4] * r * g1[0], v[hh * 8 + 5] * r * g1[1], v[hh * 8 + 6] * r * g1[2], v[hh * 8 + 7] * r * g1[3]};
            *(f32x4*)(out + (size_t)tok * DM + c0) = o0; *(f32x4*)(out + (size_t)tok * DM + c0 + 4) = o1; }
    }
}
__device__ __forceinline__ void hyena_phase(Frame& F) {
#if HY_NAIVE
    hyena_naive(F);
#else
    hyena_mfma(F);
#endif
}
__device__ __forceinline__ void natten_phase(Frame& F) {
#if NA_NAIVE
    natten_naive(F);
#else
    natten_mfma(F);
#endif
}
__device__ __forceinline__ void router_phase(Frame& F) {
#if RT_NAIVE
    router_naive(F);
#else
    router_mfma(F);
#endif
}
__device__ __forceinline__ void moe_phase_a(Frame& F) {
#if MOE_NAIVE
    moe_naive(F);
#else
    moe_gemm1(F);
#endif
}
__device__ __forceinline__ void moe_phase_b(Frame& F) {
#if MOE_NAIVE
    (void)F;
#else
    moe_gemm2(F);
#endif
}
constexpr int N_PHASES = 11;
constexpr int N_LAUNCHES = MK_N_LAUNCHES;
struct Args { const float* in[30]; float* out; unsigned char* ws; int ph_lo, ph_hi; };
#ifndef PG8_SP2
#define PG8_SP2 true
#endif
#ifndef PG8_ALIGN
#define PG8_ALIGN true
#endif
__global__ void __launch_bounds__(NWAVES * 64, 2) fwd_kernel(Args args) {
    extern __shared__ __attribute__((aligned(16))) unsigned char lds[];
    Frame F;
    F.lds = (LAS unsigned char*)lds;
    F.MISC = (volatile LAS unsigned*)(F.lds + MISC_OFF);
    F.tid = threadIdx.x; F.lane = F.tid & 63; F.wave = __builtin_amdgcn_readfirstlane(F.tid >> 6);
    F.G = gridDim.x; { const int bx = blockIdx.x; F.vcu = (F.G % 8 == 0) ? (bx % 8) * (F.G / 8) + bx / 8 : bx; }
    F.ws = args.ws; F.in = args.in; F.out = args.out;
    F.ctl = (gu32*)(F.ws + WS_CTL);
    for (int u = F.tid; u < (LDS_BYTES - LDSCTL_OFF) / 4; u += NWAVES * 64) ((LAS unsigned*)(F.lds + LDSCTL_OFF))[u] = 0u;
    __syncthreads();
    XcdBarrier bar; bar.bar = (unsigned*)(F.ctl + CW_BAR); bar.x = 0; bar.st = nullptr;
    if (N_LAUNCHES == 1) bar = xcd_barrier_post((unsigned*)(F.ctl + CW_BAR), F.MISC + 8);
#define GRID_BAR() do { if (N_LAUNCHES == 1) xcd_barrier(bar); } while (0)
    const int lo = args.ph_lo, hi = args.ph_hi;
#ifndef PH_MASK
#define PH_MASK 0xFFFF
#endif
#define IN(k) (((PH_MASK >> (k)) & 1) && lo <= (k) && (k) < hi)
#define BOTH(k) (IN(k) && IN((k) + 1))

    if (IN(0)) { p0_prologue(F); if (BOTH(0)) GRID_BAR(); }

    if (IN(1)) {
        { DenseSrc S; S.set(WSP(bf16, WS_XB), WSP(bf16, WS_WIN), M, UTR, DM, F.G, (int)blockIdx.x);
          EpiUT E{WSP(bf16, WS_UT), WSP(float, WS_RSX)};
          pg8::gemm_phase<EpiUT, DenseSrc, false, false, PG8_ALIGN, PG8_SP2>(F.lds + RING_OFF, DM, S, E); }
        { DenseSrc S; S.set(WSP(bf16, WS_XB), WSP(bf16, WS_WIN) + (size_t)UTR * DM, M, 1024, DM, F.G, (int)blockIdx.x);
          EpiQK E{WSP(bf16, WS_Q), WSP(bf16, WS_K), WSP(float, WS_RSX)};
          pg8::gemm_phase<EpiQK, DenseSrc, true, false, PG8_ALIGN, PG8_SP2>(F.lds + RING_OFF, DM, S, E); }
        if (BOTH(1)) GRID_BAR();
    }

    if (IN(2)) { hyena_phase(F); __syncthreads(); natten_phase(F); if (BOTH(2)) GRID_BAR(); }

    if (IN(3)) { mixnorm(F); if (BOTH(3)) GRID_BAR(); }

    if (IN(4)) {
        DenseSrc S; S.set(WSP(bf16, WS_MIX), WSP(bf16, WS_WOUT), M, DM, DM, F.G, (int)blockIdx.x);
        EpiH1 E{WSP(bf16, WS_H1), F.in[0]};
        pg8::gemm_phase<EpiH1, DenseSrc, true, false, PG8_ALIGN, PG8_SP2>(F.lds + RING_OFF, DM, S, E);
        if (BOTH(4)) GRID_BAR();
    }

    if (IN(5)) { router_phase(F); if (BOTH(5)) GRID_BAR(); }

    if (IN(6)) { moe_phase_a(F); if (BOTH(6)) GRID_BAR(); }

    if (IN(7)) { moe_phase_b(F); if (BOTH(7)) GRID_BAR(); }

    if (IN(8)) {
        combine(F);
        __syncthreads();
        DenseSrc S; S.set(WSP(bf16, WS_PB), WSP(bf16, WS_WP), M, DM, PLE, F.G, (int)blockIdx.x);
        EpiPL E{WSP(bf16, WS_PL)};
        pg8::gemm_phase<EpiPL, DenseSrc, true, false, PG8_ALIGN, PG8_SP2>(F.lds + RING_OFF, PLE, S, E);
        if (BOTH(8)) GRID_BAR();
    }

    if (IN(9)) {
        DenseSrc S; S.set(WSP(bf16, WS_H2), WSP(bf16, WS_WG), M, DM, DM, F.G, (int)blockIdx.x);
        EpiPLE E{WSP(bf16, WS_H3), WSP(bf16, WS_H2), WSP(bf16, WS_PL), WSP(float, WS_RS2)};
        pg8::gemm_phase<EpiPLE, DenseSrc, true, false, PG8_ALIGN, PG8_SP2>(F.lds + RING_OFF, DM, S, E);
        if (BOTH(9)) GRID_BAR();
    }

    if (IN(10)) { final_norm(F); }
#undef IN
#undef BOTH
}

extern "C" void kernel_launch(void* const* d_in, const int* in_sizes, int n_in, void* d_out, int out_size, void* d_ws, size_t ws_size, hipStream_t stream) {
    static int grid = 0;
    if (grid == 0) {
        if (n_in != 30 || in_sizes[0] != M * DM || out_size != M * DM || ws_size < WS_END) { fprintf(stderr, "kernel_launch: unexpected shapes (n_in %d, in0 %d, out %d, ws %zu); nothing launched\n", n_in, n_in > 0 ? in_sizes[0] : -1, out_size, ws_size); grid = -1; return; }
        int dev = 0, cus = 0, per_cu = 0;
        if (hipGetDevice(&dev) != hipSuccess || hipDeviceGetAttribute(&cus, hipDeviceAttributeMultiprocessorCount, dev) != hipSuccess) { fprintf(stderr, "kernel_launch: device query failed\n"); grid = -1; return; }
        if (hipFuncSetAttribute((const void*)fwd_kernel, hipFuncAttributeMaxDynamicSharedMemorySize, LDS_BYTES) != hipSuccess) { fprintf(stderr, "kernel_launch: hipFuncSetAttribute failed\n"); grid = -1; return; }
        if (hipOccupancyMaxActiveBlocksPerMultiprocessor(&per_cu, (const void*)fwd_kernel, NWAVES * 64, LDS_BYTES) != hipSuccess || per_cu < 1) { fprintf(stderr, "kernel_launch: occupancy query reports %d\n", per_cu); }
        (void)hipGetLastError();
        grid = cus;
    }
    if (grid < 0) return;
    if (hipMemsetAsync((char*)d_ws + WS_CTL, 0, CTL_ZERO_BYTES, stream) != hipSuccess) { fprintf(stderr, "kernel_launch: memset failed\n"); return; }
    Args a{};
    for (int i = 0; i < 30; ++i) a.in[i] = (const float*)d_in[i];
    a.out = (float*)d_out; a.ws = (unsigned char*)d_ws;
    if (N_LAUNCHES == 1) {
        a.ph_lo = 0; a.ph_hi = N_PHASES;
        hipLaunchKernelGGL(fwd_kernel, dim3(grid), dim3(NWAVES * 64), LDS_BYTES, stream, a);
    } else {
        for (int li = 0; li < N_PHASES; ++li) {
#if MOE_NAIVE
            if (li == 7) continue;
#endif
            a.ph_lo = li; a.ph_hi = li + 1;
            hipLaunchKernelGGL(fwd_kernel, dim3(grid), dim3(NWAVES * 64), LDS_BYTES, stream, a);
        }
    }
    const hipError_t le = hipPeekAtLastError();
    if (le != hipSuccess) fprintf(stderr, "kernel_launch: launch failed: %s\n", hipGetErrorName(le));
}
```

```cpp
#define MK_N_LAUNCHES 1
#define RT_NAIVE 0
#define MOE_NAIVE 0
#define HY_NAIVE 0
#define NA_NAIVE 0
#include <hip/hip_runtime.h>
#include <cstdio>
#include <cstdint>
#ifndef MK_N_LAUNCHES
#define MK_N_LAUNCHES 1
#endif
#ifndef HY_NAIVE
#define HY_NAIVE 1
#endif
#ifndef NA_NAIVE
#define NA_NAIVE 1
#endif
#ifndef RT_NAIVE
#define RT_NAIVE 1
#endif
#ifndef MOE_NAIVE
#define MOE_NAIVE 1
#endif
namespace pg8 {
#define PG8_LAS __attribute__((address_space(3)))
typedef unsigned short bf16_t;
typedef short bf16x8 __attribute__((ext_vector_type(8)));
typedef float f32x4 __attribute__((ext_vector_type(4)));
typedef float f32x2 __attribute__((ext_vector_type(2)));
typedef unsigned u32x4 __attribute__((ext_vector_type(4)));
typedef unsigned u32x2 __attribute__((ext_vector_type(2)));
constexpr int BM = 256, BK = 64, HALF = 128, HTB = HALF * BK * 2  , STAGE_BYTES = 8 * HTB, NXCD = 8, WGM = 8;

__host__ __device__ __forceinline__ int lds_byte(int r, int c) { const int st = (r >> 4) * 2 + (c >> 5), rr = r & 15, cc = c & 31, ob = rr * 64 + cc * 2; return st * 1024 + (ob ^ (((ob >> 9) & 1) << 5)); }
__host__ __device__ __forceinline__ void stage_rc(int b, int& R, int& C) { const int st = b / 1024, sb = b % 1024, swz = sb ^ (((sb >> 9) & 1) << 5); R = (st >> 1) * 16 + swz / 64; C = (st & 1) * 32 + (swz % 64) / 2; }
__host__ __device__ __forceinline__ int perm32(int rho) { const int n = rho >> 4, i = rho & 15; return 8 * (i >> 2) + 4 * n + (i & 3); }

struct Unit { int pm, pn, e, aux; };

struct StaticOrder {
    int nM, nN, nwg, G, c;
    __host__ __device__ void init(int M, int N, int G_, int c_) { nM = M / BM; nN = N / BM; nwg = nM * nN; G = G_; c = c_; }
    __host__ __device__ bool next(int i, Unit& u) const {
        const long L = (long)i * G + c; if (L >= nwg) return false;
        int wgid = (int)L; { const int q = nwg / NXCD, r = nwg % NXCD, xcd = wgid % NXCD, off = wgid / NXCD; wgid = (xcd < r ? xcd * (q + 1) : r * (q + 1) + (xcd - r) * q) + off; }
        const int nig = WGM * nN, gid = wgid / nig, fm = gid * WGM, gsz = (nM - fm) < WGM ? (nM - fm) : WGM;
        u.pm = fm + ((wgid % nig) % gsz); u.pn = (wgid % nig) / gsz; u.e = 0; u.aux = 0; return true;
    }
};

__device__ __forceinline__ unsigned cvt_pk_bf16(float lo, float hi) { unsigned r; asm volatile("v_cvt_pk_bf16_f32 %0, %1, %2" : "=v"(r) : "v"(lo), "v"(hi)); return r; }

template <class Epi, class Src, bool TACC, bool GATHER, bool ALIGN_EPI, bool SP2>
__device__ __forceinline__ void gemm_phase(PG8_LAS unsigned char* lds, const int K, const Src& S, const Epi& E) {
    const int tid = threadIdx.x, wid = __builtin_amdgcn_readfirstlane(tid >> 6), lane = tid & 63, wr = wid >> 2, wc = wid & 3, fr = lane & 15, fq = lane >> 4;
    const int nt = K / BK;
    int Rr[2], Cc[2]; unsigned voffB[2];
#pragma unroll
    for (int i = 0; i < 2; ++i) { int R, C; stage_rc(tid * 16 + i * 8192, R, C); const int Rb = Epi::PERM ? ((R & ~31) + perm32(R & 31)) : R;
        Rr[i] = R; Cc[i] = C; voffB[i] = (unsigned)(Rb * K + C) * 2u; }
    const size_t kstep = (size_t)(BK * 2);
    const size_t hstep = (size_t)HALF * K * 2;
    const unsigned ldsw = (unsigned)wid * 1024u;
    const int aoff = lds_byte(wr * 64 + fr, fq * 8), boff = lds_byte(wc * 32 + fr, fq * 8);
#define PG8_SA(b, h) (((b) * 2 + (h)) * HTB)
#define PG8_SB(b, h) ((4 + (b) * 2 + (h)) * HTB)
#define PG8_STAGE(bufoff, gbase, voff) do { _Pragma("unroll") for (int _i = 0; _i < 2; ++_i) \
        __builtin_amdgcn_global_load_lds((const unsigned*)((const char*)(gbase) + (voff)[_i]), (PG8_LAS unsigned*)(lds + (bufoff) + ldsw + _i * 8192), 16, 0, 0); } while (0)
#define PG8_LDA(dst, b, h) do { _Pragma("unroll") for (int m = 0; m < 4; ++m) _Pragma("unroll") for (int k = 0; k < 2; ++k) dst[m][k] = *(const PG8_LAS bf16x8*)(lds + PG8_SA(b, h) + aoff + m * 2048 + k * 1024); } while (0)
#define PG8_LDB(dst, b, h) do { _Pragma("unroll") for (int n = 0; n < 2; ++n) _Pragma("unroll") for (int k = 0; k < 2; ++k) dst[n][k] = *(const PG8_LAS bf16x8*)(lds + PG8_SB(b, h) + boff + n * 2048 + k * 1024); } while (0)
#define PG8_MMA(ai, bj, At, Bt) do { __builtin_amdgcn_s_setprio(1); _Pragma("unroll") for (int m = 0; m < 4; ++m) _Pragma("unroll") for (int n = 0; n < 2; ++n) _Pragma("unroll") for (int k = 0; k < 2; ++k) \
        acc[ai][bj][m][n] = TACC ? __builtin_amdgcn_mfma_f32_16x16x32_bf16(Bt[n][k], At[m][k], acc[ai][bj][m][n], 0, 0, 0) \
                                 : __builtin_amdgcn_mfma_f32_16x16x32_bf16(At[m][k], Bt[n][k], acc[ai][bj][m][n], 0, 0, 0); __builtin_amdgcn_s_setprio(0); } while (0)
#define PG8_WAIT_V(n) asm volatile("s_waitcnt vmcnt(" #n ")" ::: "memory")
#define PG8_WAIT_L(n) asm volatile("s_waitcnt lgkmcnt(" #n ")" ::: "memory")
#define PG8_BAR __builtin_amdgcn_s_barrier()
#define PG8_SCHED __builtin_amdgcn_sched_barrier(0)
    Unit cur, nxt; int ui = 0;
    if (!S.next(0, cur)) return;
    f32x4 acc[2][2][4][2];
#pragma unroll
    for (int a = 0; a < 2; ++a)
#pragma unroll
        for (int b = 0; b < 2; ++b)
#pragma unroll
            for (int m = 0; m < 4; ++m)
#pragma unroll
                for (int n = 0; n < 2; ++n) acc[a][b][m][n] = (f32x4){0.f, 0.f, 0.f, 0.f};
    bf16x8 At[4][2], B0[2][2], B1[2][2];
    unsigned offA[2][2], nOffA[2][2];
    S.aoff(cur, K, Rr, Cc, offA);
    const char* cA = S.abase(cur); const char* cB = S.bbase(cur);
    if constexpr (SP2) {
        PG8_STAGE(PG8_SB(0, 0), cB, voffB); PG8_STAGE(PG8_SB(0, 1), cB + hstep, voffB); PG8_STAGE(PG8_SA(0, 0), cA, offA[0]); PG8_STAGE(PG8_SA(0, 1), cA, offA[1]);
        if (wr == 1) PG8_BAR;
        PG8_WAIT_V(2); PG8_BAR;
        PG8_STAGE(PG8_SB(1, 0), cB + kstep, voffB); PG8_STAGE(PG8_SA(1, 0), cA + kstep, offA[0]); PG8_STAGE(PG8_SB(1, 1), cB + hstep + kstep, voffB);
        PG8_WAIT_V(6); PG8_BAR;
    } else {
        PG8_STAGE(PG8_SB(0, 0), cB, voffB); PG8_STAGE(PG8_SA(0, 0), cA, offA[0]); PG8_STAGE(PG8_SB(0, 1), cB + hstep, voffB); PG8_STAGE(PG8_SA(0, 1), cA, offA[1]);
        if (wr == 1) PG8_BAR;
        PG8_WAIT_V(4); PG8_BAR;
        PG8_STAGE(PG8_SB(1, 0), cB + kstep, voffB); PG8_STAGE(PG8_SA(1, 0), cA + kstep, offA[0]); PG8_STAGE(PG8_SB(1, 1), cB + hstep + kstep, voffB);
        PG8_WAIT_V(6); PG8_BAR;
    }
    for (;;) {
        const bool has_next = S.next(ui + 1, nxt);
        const char* nA = has_next ? S.abase(nxt) : cA; const char* nB = has_next ? S.bbase(nxt) : cB;
        if constexpr (GATHER) {
            if (has_next) S.aoff(nxt, K, Rr, Cc, nOffA);
            else {
#pragma unroll
                for (int h = 0; h < 2; ++h)
#pragma unroll
                    for (int i = 0; i < 2; ++i) nOffA[h][i] = offA[h][i]; }
        }
#pragma nounroll
        for (int t = 0; t < nt; t += 2) {
            const bool last = (t == nt - 2);
            const char* a1 = cA + (size_t)(t + 1) * kstep;
            const char* a2 = last ? nA : cA + (size_t)(t + 2) * kstep; const char* b2 = last ? nB : cB + (size_t)(t + 2) * kstep;
            const char* a3 = a2 + kstep; const char* b3 = b2 + kstep;
            unsigned o2[2][2];
#pragma unroll
            for (int h = 0; h < 2; ++h)
#pragma unroll
                for (int i = 0; i < 2; ++i) o2[h][i] = (GATHER && last) ? nOffA[h][i] : offA[h][i];
            if constexpr (SP2) {
            PG8_LDB(B0, 0, 0); PG8_LDB(B1, 0, 1); PG8_SCHED; PG8_LDA(At, 0, 0); PG8_STAGE(PG8_SA(1, 1), a1, offA[1]);
            PG8_WAIT_V(8); PG8_WAIT_L(0); PG8_BAR; PG8_MMA(0, 0, At, B0); PG8_MMA(0, 1, At, B1); PG8_BAR; PG8_SCHED;
            PG8_LDA(At, 0, 1); PG8_STAGE(PG8_SB(0, 0), b2, voffB); PG8_STAGE(PG8_SB(0, 1), b2 + hstep, voffB); PG8_STAGE(PG8_SA(0, 0), a2, o2[0]);
            PG8_WAIT_V(8); PG8_WAIT_L(0); PG8_BAR; PG8_MMA(1, 0, At, B0); PG8_MMA(1, 1, At, B1); PG8_BAR; PG8_SCHED;
            PG8_LDB(B0, 1, 0); PG8_LDB(B1, 1, 1); PG8_SCHED; PG8_LDA(At, 1, 0); PG8_STAGE(PG8_SA(0, 1), a2, o2[1]);
            PG8_WAIT_V(8); PG8_WAIT_L(0); PG8_BAR; PG8_MMA(0, 0, At, B0); PG8_MMA(0, 1, At, B1); PG8_BAR; PG8_SCHED;
            PG8_LDA(At, 1, 1); PG8_STAGE(PG8_SB(1, 0), b3, voffB); PG8_STAGE(PG8_SB(1, 1), b3 + hstep, voffB); PG8_STAGE(PG8_SA(1, 0), a3, o2[0]);
            PG8_WAIT_V(8); PG8_WAIT_L(0); PG8_BAR; PG8_MMA(1, 0, At, B0); PG8_MMA(1, 1, At, B1); PG8_BAR; PG8_SCHED;
            } else {
            PG8_LDB(B0, 0, 0); PG8_SCHED; PG8_LDA(At, 0, 0); PG8_STAGE(PG8_SA(1, 1), a1, offA[1]);
            PG8_WAIT_L(8); PG8_BAR; PG8_WAIT_L(0); PG8_MMA(0, 0, At, B0); PG8_BAR; PG8_SCHED;
            PG8_LDB(B1, 0, 1); PG8_STAGE(PG8_SB(0, 0), b2, voffB);
            PG8_BAR; PG8_WAIT_L(0); PG8_MMA(0, 1, At, B1); PG8_BAR;
            PG8_LDA(At, 0, 1); PG8_STAGE(PG8_SA(0, 0), a2, o2[0]);
            PG8_BAR; PG8_WAIT_L(0); PG8_MMA(1, 0, At, B0); PG8_BAR; PG8_SCHED;
            PG8_STAGE(PG8_SB(0, 1), b2 + hstep, voffB);
            PG8_WAIT_V(6); PG8_BAR; PG8_MMA(1, 1, At, B1); PG8_BAR;
            PG8_LDB(B0, 1, 0); PG8_SCHED; PG8_LDA(At, 1, 0); PG8_STAGE(PG8_SA(0, 1), a2, o2[1]);
            PG8_WAIT_L(8); PG8_BAR; PG8_WAIT_L(0); PG8_MMA(0, 0, At, B0); PG8_BAR; PG8_SCHED;
            PG8_LDB(B1, 1, 1); PG8_STAGE(PG8_SB(1, 0), b3, voffB);
            PG8_BAR; PG8_WAIT_L(0); PG8_MMA(0, 1, At, B1); PG8_BAR;
            PG8_LDA(At, 1, 1); PG8_STAGE(PG8_SA(1, 0), a3, o2[0]);
            PG8_BAR; PG8_WAIT_L(0); PG8_MMA(1, 0, At, B0); PG8_BAR; PG8_SCHED;
            PG8_STAGE(PG8_SB(1, 1), b3 + hstep, voffB);
            PG8_WAIT_V(6); PG8_BAR; PG8_MMA(1, 1, At, B1); PG8_BAR;
            }
        }
        if constexpr (ALIGN_EPI) { if (wr == 0) PG8_BAR; }
        E(acc, cur, wr, wc, fr, fq);
        if (!has_next) break;
#pragma unroll
        for (int a = 0; a < 2; ++a)
#pragma unroll
            for (int b = 0; b < 2; ++b)
#pragma unroll
                for (int m = 0; m < 4; ++m)
#pragma unroll
                    for (int n = 0; n < 2; ++n) acc[a][b][m][n] = (f32x4){0.f, 0.f, 0.f, 0.f};
        cur = nxt; cA = nA; cB = nB; ++ui;
        if constexpr (GATHER) {
#pragma unroll
            for (int h = 0; h < 2; ++h)
#pragma unroll
                for (int i = 0; i < 2; ++i) offA[h][i] = nOffA[h][i]; }
        if constexpr (ALIGN_EPI) { if (wr == 1) PG8_BAR; }
    }
    PG8_WAIT_V(0);
    if constexpr (!ALIGN_EPI) { if (wr == 0) PG8_BAR; }
    PG8_BAR;
#undef PG8_SA
#undef PG8_SB
#undef PG8_STAGE
#undef PG8_LDA
#undef PG8_LDB
#undef PG8_MMA
#undef PG8_WAIT_V
#undef PG8_WAIT_L
#undef PG8_BAR
#undef PG8_SCHED
}
}
constexpr int NB = 16, SEQ = 2048, DM = 1024, M = NB * SEQ, PLE = 256;
constexpr int HYW = 512, NAW = 512, NH = 8, HD = 64, UTR = 2048;
constexpr int NE = 32, DE = 512, LCAP = M;
constexpr int GSTR = 4104;
constexpr float EPS = 1e-6f;
constexpr int NWAVES = 8;

constexpr size_t MiB = 1u << 20, KiB = 1u << 10;
constexpr size_t WS_CTL = 0, CTL_ZERO_BYTES = 1 * MiB;
constexpr size_t WS_RSX = 1 * MiB, WS_RS1 = WS_RSX + 128 * KiB, WS_RS2 = WS_RS1 + 128 * KiB;
constexpr size_t WS_WR = 1 * MiB + 512 * KiB;
constexpr size_t WS_GATE = 2 * MiB;
constexpr size_t WS_LIST = 4 * MiB;
constexpr size_t WS_WIN = 8 * MiB, WS_WOUT = 14 * MiB, WS_WG = 16 * MiB, WS_WP = 18 * MiB;
constexpr size_t WS_HYK = 20 * MiB;
constexpr size_t WS_W13 = 30 * MiB, WS_W2 = 94 * MiB;
constexpr size_t WS_PB = 126 * MiB;
constexpr size_t WS_A1 = 142 * MiB;
constexpr size_t WS_A2 = 206 * MiB;
constexpr size_t WS_A3 = 334 * MiB;
constexpr size_t WS_A4 = 414 * MiB;
constexpr size_t WS_END = 478 * MiB;
constexpr size_t WS_XB = WS_A1, WS_MIX = WS_A1, WS_YK0 = WS_A1, WS_H3 = WS_A1;
constexpr size_t WS_UT = WS_A2, WS_H1 = WS_A2, WS_H2 = WS_A2 + 64 * MiB;
constexpr size_t WS_Q = WS_A3, WS_K = WS_A3 + 32 * MiB, WS_HID = WS_A3, WS_PL = WS_A3;
constexpr size_t WS_YT = WS_A4, WS_YNA = WS_A4 + 32 * MiB, WS_YK1 = WS_A4;
static_assert(WS_HYK + (size_t)1024 * GSTR * 2 <= WS_W13 && WS_A3 + (size_t)(2 * M + NE * 256) * DE * 2 <= WS_A4, "d_ws map");
constexpr int CW_TMO = 0, CW_CODE = 1;
constexpr int CW_BAR = 4096;
constexpr int CW_CNT = 8192;
constexpr int RING_OFF = 0, RING_BYTES = 131072;
constexpr int LDS_BYTES = 147456;
constexpr int LDSCTL_OFF = LDS_BYTES - 512, TAB_OFF = LDSCTL_OFF, MISC_OFF = LDSCTL_OFF + 320;
constexpr int SCRATCH_BYTES = LDSCTL_OFF;

#define GAS __attribute__((address_space(1)))
#define LAS __attribute__((address_space(3)))
typedef unsigned short bf16;
typedef unsigned v4u __attribute__((ext_vector_type(4)));
typedef unsigned v2u __attribute__((ext_vector_type(2)));
typedef float f32x4 __attribute__((ext_vector_type(4)));
typedef short bf16x8 __attribute__((ext_vector_type(8)));
typedef GAS unsigned gu32;
#define RLX_AGENT __ATOMIC_RELAXED, __HIP_MEMORY_SCOPE_AGENT
#define LDS_WAIT() asm volatile("s_waitcnt lgkmcnt(0)" ::: "memory")
#define VM_WAIT() asm volatile("s_waitcnt vmcnt(0)" ::: "memory")
__device__ __forceinline__ unsigned f2bf(float f) { unsigned u = __builtin_bit_cast(unsigned, f); return (u + 0x7fffu + ((u >> 16) & 1u)) >> 16; }
__device__ __forceinline__ unsigned pk2(float lo, float hi) { return f2bf(lo) | (f2bf(hi) << 16); }
__device__ __forceinline__ float bf2f(unsigned b) { return __builtin_bit_cast(float, b << 16); }
__device__ __forceinline__ float bflo(unsigned w) { return __builtin_bit_cast(float, w << 16); }
__device__ __forceinline__ float bfhi(unsigned w) { return __builtin_bit_cast(float, w & 0xffff0000u); }
__device__ __forceinline__ float bfr(float f) { return bf2f(f2bf(f)); }
__device__ __forceinline__ float wave_sum(float v) {
#pragma unroll
    for (int o = 1; o < 64; o <<= 1) v += __shfl_xor(v, o);
    return v;
}

#define XB_TMO      128
#define XB_XCNT(j)  (256  + 64 * (j))
#define XB_XSUB(j)  (1280 + 64 * (j))
#define XB_XGEN(j)  (2304 + 64 * (j))
#define XB_TOP      3328
#define XB_TOPGEN   3392
#define XCD_BAR_WORDS 3456
#define XB_SPIN_CAP (1u << 18)

__device__ __forceinline__ unsigned xb_ld(unsigned* p)              { return __hip_atomic_load(p, __ATOMIC_RELAXED, __HIP_MEMORY_SCOPE_AGENT); }
__device__ __forceinline__ unsigned xb_add(unsigned* p, unsigned v) { return __hip_atomic_fetch_add(p, v, __ATOMIC_RELAXED, __HIP_MEMORY_SCOPE_AGENT); }
__device__ __forceinline__ unsigned xb_xcc_id() { return (unsigned)__builtin_amdgcn_s_getreg((3 << 11) | 20) & 0xFu; }
#define XB_SPIN(cond, bar) do { unsigned _sp = 0; while (cond) { __builtin_amdgcn_s_sleep(1); \
    if ((++_sp & 255u) == 0u) { if (xb_ld(&(bar)[XB_TMO])) break; if (_sp > XB_SPIN_CAP) { atomicAdd(&(bar)[XB_TMO], 1u); break; } } } } while (0)

struct XcdBarrier {
    unsigned* bar; unsigned x;
    volatile LAS unsigned* st;
};

__device__ __forceinline__ XcdBarrier xcd_barrier_post(unsigned* bar, volatile LAS unsigned* st) {
    XcdBarrier b; b.bar = bar; b.x = xb_xcc_id(); b.st = st;
    if (threadIdx.x == 0) (void)xb_add(&bar[XB_XCNT(b.x)], 1u);
    return b;
}
__device__ __forceinline__ void xcd_barrier_complete(unsigned* bar, unsigned x, unsigned& nloc, unsigned& nx) {
    const unsigned G = gridDim.x * gridDim.y * gridDim.z;
    unsigned sum, cnt, mine, sp = 0u;
    for (;;) {
        sum = 0u; cnt = 0u; mine = 0u;
#pragma unroll
        for (unsigned j = 0; j < 16; ++j) { const unsigned c = xb_ld(&bar[XB_XCNT(j)]); sum += c; cnt += (c > 0u) ? 1u : 0u; mine = (j == x) ? c : mine; }
        if (sum == G) break;
        __builtin_amdgcn_s_sleep(1);
        if ((++sp & 255u) == 0u) { if (xb_ld(&bar[XB_TMO])) break; if (sp > XB_SPIN_CAP) { atomicAdd(&bar[XB_TMO], 1u); break; } }
    }
    nloc = mine > 0u ? mine : 1u; nx = cnt > 0u ? cnt : 1u;
}

__device__ __forceinline__ void xcd_barrier(const XcdBarrier& b) {
    asm volatile("s_waitcnt vmcnt(0)" ::: "memory");
    __syncthreads();
    if (threadIdx.x == 0) {
        unsigned* bar = b.bar;
        __builtin_amdgcn_s_waitcnt(0);
        unsigned nloc = b.st[0], nx = b.st[1];
        if (nloc == 0u) { xcd_barrier_complete(bar, b.x, nloc, nx); b.st[0] = nloc; b.st[1] = nx; }
        const unsigned old = xb_add(&bar[XB_XSUB(b.x)], 1u);
        const unsigned gen = old / nloc;
        if (old + 1u == (gen + 1u) * nloc) {
            __builtin_amdgcn_fence(__ATOMIC_RELEASE, "agent");
            asm volatile("s_waitcnt vmcnt(0)" ::: "memory");
            const unsigned og = xb_add(&bar[XB_TOP], 1u);
            const unsigned tg = og / nx;
            if (og + 1u == (tg + 1u) * nx) xb_add(&bar[XB_TOPGEN], 1u);
            else XB_SPIN(xb_ld(&bar[XB_TOPGEN]) == tg, bar);
            __builtin_amdgcn_fence(__ATOMIC_ACQUIRE, "agent");
            xb_add(&bar[XB_XGEN(b.x)], 1u);
            asm volatile("s_waitcnt vmcnt(0)" ::: "memory");
        } else {
            XB_SPIN(xb_ld(&bar[XB_XGEN(b.x)]) == gen, bar);
            __builtin_amdgcn_fence(__ATOMIC_ACQUIRE, "agent");
            asm volatile("s_waitcnt vmcnt(0)" ::: "memory");
        }
    }
    __syncthreads();
}
struct Frame {
    LAS unsigned char* lds;
    volatile LAS unsigned* MISC;
    gu32* ctl;
    int tid, lane, wave;
    int vcu, G;
    const float* const* in; float* out; unsigned char* ws;
};
#define WSP(T, off) ((T*)(F.ws + (off)))

struct DenseSrc : pg8::StaticOrder {
    const char* A; const char* B; size_t tstepA, tstepB;
    __device__ __forceinline__ void set(const void* A_, const void* B_, int M_, int N_, int K_, int G_, int c_) { init(M_, N_, G_, c_); A = (const char*)A_; B = (const char*)B_; tstepA = (size_t)256 * K_ * 2; tstepB = (size_t)256 * K_ * 2; }
    __device__ __forceinline__ const char* abase(const pg8::Unit& u) const { return A + (size_t)u.pm * tstepA; }
    __device__ __forceinline__ const char* bbase(const pg8::Unit& u) const { return B + (size_t)u.pn * tstepB; }
    __device__ __forceinline__ void aoff(const pg8::Unit&, int K, const int (&R)[2], const int (&C)[2], unsigned (&off)[2][2]) const {
#pragma unroll
        for (int h = 0; h < 2; ++h)
#pragma unroll
            for (int i = 0; i < 2; ++i) off[h][i] = (unsigned)((128 * h + R[i]) * K + C[i]) * 2u;
    }
};

using pg8::f32x4; using pg8::Unit;
struct EpiUT {
    static constexpr bool PERM = false;
    bf16* UT; const float* rstd;
    __device__ __forceinline__ void operator()(const f32x4 (&acc)[2][2][4][2], const Unit& u, int wr, int wc, int fr, int fq) const {
#pragma unroll
        for (int ai = 0; ai < 2; ++ai)
#pragma unroll
            for (int m = 0; m < 4; ++m) {
                const int tok0 = u.pm * 256 + ai * 128 + wr * 64 + m * 16 + 4 * fq;
                const f32x4 rs = *(const f32x4*)(rstd + tok0);
#pragma unroll
                for (int bj = 0; bj < 2; ++bj)
#pragma unroll
                    for (int n = 0; n < 2; ++n) {
                        const int col = u.pn * 256 + bj * 128 + wc * 32 + n * 16 + fr;
                        const f32x4 v = acc[ai][bj][m][n] * rs;
                        v2u w; w.x = pg8::cvt_pk_bf16(v[0], v[1]); w.y = pg8::cvt_pk_bf16(v[2], v[3]);
                        *(v2u*)(UT + (size_t)col * M + tok0) = w; }
            }
    }
};
struct EpiQK {
    static constexpr bool PERM = true;
    bf16* Q; bf16* Kp; const float* rstd;
    __device__ __forceinline__ void operator()(const f32x4 (&acc)[2][2][4][2], const Unit& u, int wr, int wc, int fr, int fq) const {
        const int row0 = u.pm * 256 + wr * 64 + fr; const int t = u.pn >> 1; bf16* base = t ? Kp : Q; const float sc = t ? 1.f : 0.125f;
        const int col0 = (u.pn & 1) * 256 + wc * 32 + 8 * fq;
#pragma unroll
        for (int ai = 0; ai < 2; ++ai)
#pragma unroll
            for (int m = 0; m < 4; ++m) { const int row = row0 + ai * 128 + m * 16; const float r = rstd[row] * sc; bf16* rowp = base + (size_t)row * 512 + col0;
#pragma unroll
                for (int bj = 0; bj < 2; ++bj) { const f32x4 v0 = acc[ai][bj][m][0] * r, v1 = acc[ai][bj][m][1] * r;
                    v4u w; w.x = pg8::cvt_pk_bf16(v0[0], v0[1]); w.y = pg8::cvt_pk_bf16(v0[2], v0[3]); w.z = pg8::cvt_pk_bf16(v1[0], v1[1]); w.w = pg8::cvt_pk_bf16(v1[2], v1[3]);
                    *(v4u*)(rowp + bj * 128) = w; } }
    }
};
struct EpiH1 {
    static constexpr bool PERM = true;
    bf16* H1; const float* x;
    __device__ __forceinline__ void operator()(const f32x4 (&acc)[2][2][4][2], const Unit& u, int wr, int wc, int fr, int fq) const {
        const int row0 = u.pm * 256 + wr * 64 + fr; const int col0 = u.pn * 256 + wc * 32 + 8 * fq;
#pragma unroll
        for (int ai = 0; ai < 2; ++ai)
#pragma unroll
            for (int m = 0; m < 4; ++m) { const size_t ro = (size_t)(row0 + ai * 128 + m * 16) * DM + col0;
#pragma unroll
                for (int bj = 0; bj < 2; ++bj) { const f32x4 x0 = *(const f32x4*)(x + ro + bj * 128), x1 = *(const f32x4*)(x + ro + bj * 128 + 4);
                    const f32x4 v0 = acc[ai][bj][m][0] + x0, v1 = acc[ai][bj][m][1] + x1;
                    v4u w; w.x = pg8::cvt_pk_bf16(v0[0], v0[1]); w.y = pg8::cvt_pk_bf16(v0[2], v0[3]); w.z = pg8::cvt_pk_bf16(v1[0], v1[1]); w.w = pg8::cvt_pk_bf16(v1[2], v1[3]);
                    *(v4u*)(H1 + ro + bj * 128) = w; } }
    }
};
struct EpiPL {
    static constexpr bool PERM = true;
    bf16* PL;
    __device__ __forceinline__ void operator()(const f32x4 (&acc)[2][2][4][2], const Unit& u, int wr, int wc, int fr, int fq) const {
        const int row0 = u.pm * 256 + wr * 64 + fr; const int col0 = u.pn * 256 + wc * 32 + 8 * fq;
#pragma unroll
        for (int ai = 0; ai < 2; ++ai)
#pragma unroll
            for (int m = 0; m < 4; ++m) { const size_t ro = (size_t)(row0 + ai * 128 + m * 16) * DM + col0;
#pragma unroll
                for (int bj = 0; bj < 2; ++bj) { const f32x4 v0 = acc[ai][bj][m][0], v1 = acc[ai][bj][m][1];
                    v4u w; w.x = pg8::cvt_pk_bf16(v0[0], v0[1]); w.y = pg8::cvt_pk_bf16(v0[2], v0[3]); w.z = pg8::cvt_pk_bf16(v1[0], v1[1]); w.w = pg8::cvt_pk_bf16(v1[2], v1[3]);
                    *(v4u*)(PL + ro + bj * 128) = w; } }
    }
};
__device__ __forceinline__ float sigmoidf_(float v) { return 1.f / (1.f + __expf(-v)); }
struct EpiPLE {
    static constexpr bool PERM = true;
    bf16* H3; const bf16* H2; const bf16* PL; const float* rstd;
    __device__ __forceinline__ void operator()(const f32x4 (&acc)[2][2][4][2], const Unit& u, int wr, int wc, int fr, int fq) const {
        const int row0 = u.pm * 256 + wr * 64 + fr; const int col0 = u.pn * 256 + wc * 32 + 8 * fq;
#pragma unroll
        for (int ai = 0; ai < 2; ++ai)
#pragma unroll
            for (int m = 0; m < 4; ++m) { const int row = row0 + ai * 128 + m * 16; const size_t ro = (size_t)row * DM + col0; const float r = rstd[row];
#pragma unroll
                for (int bj = 0; bj < 2; ++bj) { const v4u h = *(const v4u*)(H2 + ro + bj * 128), p = *(const v4u*)(PL + ro + bj * 128);
                    const f32x4 a0 = acc[ai][bj][m][0] * r, a1 = acc[ai][bj][m][1] * r;
                    float o[8];
                    o[0] = bflo(h.x) + bflo(p.x) * sigmoidf_(a0[0]); o[1] = bfhi(h.x) + bfhi(p.x) * sigmoidf_(a0[1]);
                    o[2] = bflo(h.y) + bflo(p.y) * sigmoidf_(a0[2]); o[3] = bfhi(h.y) + bfhi(p.y) * sigmoidf_(a0[3]);
                    o[4] = bflo(h.z) + bflo(p.z) * sigmoidf_(a1[0]); o[5] = bfhi(h.z) + bfhi(p.z) * sigmoidf_(a1[1]);
                    o[6] = bflo(h.w) + bflo(p.w) * sigmoidf_(a1[2]); o[7] = bfhi(h.w) + bfhi(p.w) * sigmoidf_(a1[3]);
                    v4u w; w.x = pg8::cvt_pk_bf16(o[0], o[1]); w.y = pg8::cvt_pk_bf16(o[2], o[3]); w.z = pg8::cvt_pk_bf16(o[4], o[5]); w.w = pg8::cvt_pk_bf16(o[6], o[7]);
                    *(v4u*)(H3 + ro + bj * 128) = w; } }
    }
};

template <class GainF, class RowF>
__device__ __forceinline__ void p0_transpose_item(const float* W, int N, bf16* WT, int ldk, LAS float* scr, int item, int lane, GainF gain, RowF rowmap) {
    const int nblk = N / 32, kb = item / nblk, nb = item % nblk, k0 = 64 * kb, n0 = 32 * nb;
#pragma unroll 8
    for (int i = 0; i < 32; ++i) { const int kk = 2 * i + (lane >> 5); scr[kk * 33 + (lane & 31)] = W[(size_t)(k0 + kk) * N + n0 + (lane & 31)] * gain(k0 + kk); }
    LDS_WAIT(); asm volatile("" ::: "memory");
    const int c = lane & 7;
#pragma unroll
    for (int j = 0; j < 4; ++j) { const int n = (lane >> 3) + 8 * j; const LAS float* s = scr + (8 * c) * 33 + n;
        v4u o; o.x = pk2(s[0 * 33], s[1 * 33]); o.y = pk2(s[2 * 33], s[3 * 33]); o.z = pk2(s[4 * 33], s[5 * 33]); o.w = pk2(s[6 * 33], s[7 * 33]);
        *(GAS v4u*)(WT + (size_t)rowmap(n0 + n) * ldk + k0 + 8 * c) = o; }
    LDS_WAIT(); asm volatile("" ::: "memory");
}
__device__ __forceinline__ void p0_filter_task(Frame& F, int task) {
    const int lane = F.lane, n0 = task * 4;
    const float* w1 = F.in[6]; const float* b1 = F.in[7]; const float* f1 = F.in[8]; const float* w2 = F.in[9]; const float* b2 = F.in[10]; const float* f2 = F.in[11]; const float* w3 = F.in[12];
    bf16* HYK = WSP(bf16, WS_HYK);
    float h2[4];
#pragma unroll
    for (int p = 0; p < 4; ++p) {
        const int n = n0 + p; const float t = (float)n * (1.0f / 2047.0f); const float w = 6.283185307179586f * (float)n * (1.0f / 2048.0f);
        float z = 0.f;
        if (lane == 0) z = t;
        else if (lane <= 16) { const float band = 1e-4f + (float)(lane - 1) * ((15.0f - 1e-4f) / 15.0f); z = cosf(band * w); }
        else if (lane <= 32) { const float band = 1e-4f + (float)(lane - 17) * ((15.0f - 1e-4f) / 15.0f); z = -sinf(band * w); }
        float a = b1[lane];
#pragma unroll
        for (int i = 0; i < 33; ++i) a += __shfl(z, i) * w1[i * 64 + lane];
        const float h1 = sinf(f1[lane] * a);
        float a2 = b2[lane];
#pragma unroll 16
        for (int j = 0; j < 64; ++j) a2 += __shfl(h1, j) * w2[j * 64 + lane];
        h2[p] = sinf(f2[lane] * a2);
    }
#pragma nounroll
    for (int qt = 0; qt < 4; ++qt) {
        float acc[8][4];
#pragma unroll
        for (int i = 0; i < 8; ++i)
#pragma unroll
            for (int p = 0; p < 4; ++p) acc[i][p] = 0.f;
#pragma nounroll
        for (int j = 0; j < 64; ++j) {
            float hj[4];
#pragma unroll
            for (int p = 0; p < 4; ++p) hj[p] = __shfl(h2[p], j);
#pragma unroll
            for (int i = 0; i < 8; ++i) { const float wv = w3[(size_t)j * 2048 + (qt * 8 + i) * 64 + lane];
#pragma unroll
                for (int p = 0; p < 4; ++p) acc[i][p] += hj[p] * wv; }
        }
#pragma unroll
        for (int i = 0; i < 8; ++i) {
            const int col = (qt * 8 + i) * 64 + lane, dir = col >> 10, o = (col >> 9) & 1, c = col & 511;
            const float dl = 3.0701134573253944f + (float)c * ((15.350567286626972f - 3.0701134573253944f) / 511.0f);
#pragma unroll
            for (int p = 0; p < 4; ++p) { const int n = n0 + p; const float t = (float)n * (1.0f / 2047.0f);
                const float val = acc[i][p] * expf(-t * dl);
                const int q = dir ? 2048 + n : 2048 - n;
                if (!(dir == 1 && n == 0)) HYK[(size_t)(o * 512 + c) * GSTR + q] = (bf16)f2bf(val); }
        }
    }
}
__device__ __forceinline__ void p0_prologue(Frame& F) {
    LAS float* scr = (LAS float*)(F.lds + RING_OFF + F.wave * 16384);
    const int gw = F.vcu * NWAVES + F.wave, NGW = F.G * NWAVES, lane = F.lane;
    for (int task = gw; task < 512; task += NGW) p0_filter_task(F, task);
    { bf16* HYK = WSP(bf16, WS_HYK);
      for (int i = blockIdx.x * 512 + F.tid; i < 1024 * 9; i += F.G * 512) { const int row = i / 9, j = i % 9; HYK[(size_t)row * GSTR + (j == 0 ? 0 : 4095 + j)] = 0; } }
    {
        const float* g_mix = F.in[2]; const float* g_ohy = F.in[15]; const float* g_ona = F.in[16]; const float* g_ffn = F.in[18]; const float* g_ple = F.in[26];
        constexpr int I_IN = 16 * 96, I_OUT = 16 * 32, I_G = 16 * 32, I_P = 4 * 32, I_E1 = 16 * 16, I_E2 = 8 * 32;
        constexpr int NITEMS = I_IN + I_OUT + I_G + I_P + NE * (2 * I_E1 + I_E2);
        for (int it = gw; it < NITEMS; it += NGW) {
            int r = it;
            if (r < I_IN) { p0_transpose_item(F.in[3], 3072, WSP(bf16, WS_WIN), DM, scr, r, lane, [&](int k) { return g_mix[k]; },
                                              [](int n) { return n < 1536 ? n : (n < 2560 ? n + 512 : n - 1024); }); continue; } r -= I_IN;
            if (r < I_OUT) { p0_transpose_item(F.in[17], 1024, WSP(bf16, WS_WOUT), DM, scr, r, lane, [&](int k) { return k < 512 ? g_ohy[k] : g_ona[k - 512]; }, [](int n) { return n; }); continue; } r -= I_OUT;
            if (r < I_G) { p0_transpose_item(F.in[27], 1024, WSP(bf16, WS_WG), DM, scr, r, lane, [&](int k) { return g_ple[k]; }, [](int n) { return n; }); continue; } r -= I_G;
            if (r < I_P) { p0_transpose_item(F.in[28], 1024, WSP(bf16, WS_WP), PLE, scr, r, lane, [](int) { return 1.0f; }, [](int n) { return n; }); continue; } r -= I_P;
            const int e = r / (2 * I_E1 + I_E2); r -= e * (2 * I_E1 + I_E2);
            if (r < I_E1) { p0_transpose_item(F.in[23] + (size_t)e * DM * DE, DE, WSP(bf16, WS_W13) + (size_t)e * 1024 * DM, DM, scr, r, lane, [&](int k) { return g_ffn[k]; }, [](int n) { return (n >> 2) * 8 + (n & 3); }); continue; } r -= I_E1;
            if (r < I_E1) { p0_transpose_item(F.in[24] + (size_t)e * DM * DE, DE, WSP(bf16, WS_W13) + (size_t)e * 1024 * DM, DM, scr, r, lane, [&](int k) { return g_ffn[k]; }, [](int n) { return (n >> 2) * 8 + (n & 3) + 4; }); continue; } r -= I_E1;
            p0_transpose_item(F.in[25] + (size_t)e * DE * DM, DM, WSP(bf16, WS_W2) + (size_t)e * DM * DE, DE, scr, r, lane, [](int) { return 1.0f; }, [](int n) { return n; });
        }
        float* WR = WSP(float, WS_WR);
        for (int i = blockIdx.x * 512 + F.tid; i < 36 * 1024; i += F.G * 512) { const int j = i >> 10, k = i & 1023;
            WR[i] = (j < 4 ? F.in[19][k * 4 + j] : F.in[21][k * 32 + (j - 4)]) * g_ffn[k]; }
    }
    {
        const float* x = F.in[0]; bf16* XB = WSP(bf16, WS_XB); float* rsx = WSP(float, WS_RSX);
        for (int m = gw; m < M; m += NGW) {
            const GAS f32x4* xr = (const GAS f32x4*)(x + (size_t)m * DM) + lane;
            f32x4 v[4]; float s = 0.f;
#pragma unroll
            for (int j = 0; j < 4; ++j) { v[j] = xr[64 * j]; s += (v[j].x * v[j].x + v[j].y * v[j].y) + (v[j].z * v[j].z + v[j].w * v[j].w); }
            s = wave_sum(s);
            if (lane == 0) rsx[m] = rsqrtf(s * (1.0f / DM) + EPS);
            GAS v2u* o8 = (GAS v2u*)(XB + (size_t)m * DM) + lane;
#pragma unroll
            for (int j = 0; j < 4; ++j) { v2u w; w.x = pk2(v[j].x, v[j].y); w.y = pk2(v[j].z, v[j].w); o8[64 * j] = w; }
        }
        const float* p = F.in[1]; bf16* PB = WSP(bf16, WS_PB);
        for (int m = gw; m < M; m += NGW) {
            const f32x4 v = ((const GAS f32x4*)(p + (size_t)m * PLE))[lane];
            v2u w; w.x = pk2(v.x, v.y); w.y = pk2(v.z, v.w); ((GAS v2u*)(PB + (size_t)m * PLE))[lane] = w;
        }
    }
}

__device__ __forceinline__ float sc3(const bf16* u, int s, float w0, float w1, float w2, float cb) {
    const float um = s > 0 ? bf2f(u[s - 1]) : 0.f, u0 = bf2f(u[s]), up = s < SEQ - 1 ? bf2f(u[s + 1]) : 0.f;
    return cb + w0 * um + w1 * u0 + w2 * up;
}
__device__ __forceinline__ void hyena_naive(Frame& F) {
    LAS float* Gl = (LAS float*)F.lds; LAS float* z = Gl + 4112;
    const bf16* UT = WSP(bf16, WS_UT); const bf16* HYK = WSP(bf16, WS_HYK); bf16* YT = WSP(bf16, WS_YT);
    const float* cw = F.in[4]; const float* cbv = F.in[5]; const float* skip = F.in[13];
    const int tid = F.tid;
    for (int unit = blockIdx.x; unit < HYW * NB; unit += F.G) {
        const int c = unit / NB, b = unit % NB;
        const bf16* ux1 = UT + (size_t)c * M + b * SEQ; const bf16* ux2 = UT + (size_t)(512 + c) * M + b * SEQ; const bf16* uv = UT + (size_t)(1024 + c) * M + b * SEQ;
        __syncthreads();
        for (int s = tid; s < SEQ; s += 512) z[s] = bfr(sc3(uv, s, cw[1024 + c], cw[1536 + 1024 + c], cw[3072 + 1024 + c], cbv[1024 + c]));
        for (int o = 0; o < 2; ++o) {
            for (int q = tid; q < GSTR; q += 512) Gl[q] = bf2f(HYK[(size_t)(o * 512 + c) * GSTR + q]);
            __syncthreads();
            const int t4 = tid * 4; float acc[4] = {0.f, 0.f, 0.f, 0.f};
            for (int s = 0; s < SEQ; ++s) { const float zs = z[s];
#pragma unroll
                for (int j = 0; j < 4; ++j) acc[j] += Gl[2048 - (t4 + j) + s] * zs; }
            const bf16* ug = o ? ux2 : ux1; const int gc = o ? 512 + c : c; const float sk = skip[o * 512 + c];
            float outv[4];
#pragma unroll
            for (int j = 0; j < 4; ++j) { const float g = sc3(ug, t4 + j, cw[gc], cw[1536 + gc], cw[3072 + gc], cbv[gc]); outv[j] = g * (acc[j] + z[t4 + j] * sk); }
            __syncthreads();
            if (o == 0) {
#pragma unroll
                for (int j = 0; j < 4; ++j) z[t4 + j] = bfr(outv[j]);
            } else {
                v2u w; w.x = pk2(outv[0], outv[1]); w.y = pk2(outv[2], outv[3]); *(v2u*)(YT + (size_t)c * M + b * SEQ + t4) = w;
            }
            __syncthreads();
        }
    }
}
__device__ __forceinline__ void natten_naive(Frame& F) {
    const bf16* Q = WSP(bf16, WS_Q); const bf16* Kb = WSP(bf16, WS_K); const bf16* VT = WSP(bf16, WS_UT) + (size_t)1536 * M; bf16* YNA = WSP(bf16, WS_YNA);
    const float* rpb = F.in[14];
    for (int unit = blockIdx.x; unit < M / 64; unit += F.G) {
        const int b = unit >> 5, r = unit & 31, h = F.tid >> 6, qc = F.tid & 63;
        const int tok = b * SEQ + r * 64 + qc;
        float q[64], o[64];
#pragma unroll
        for (int d8 = 0; d8 < 8; ++d8) { const v4u w = *(const v4u*)(Q + (size_t)tok * 512 + h * 64 + d8 * 8);
            q[d8 * 8 + 0] = bflo(w.x); q[d8 * 8 + 1] = bfhi(w.x); q[d8 * 8 + 2] = bflo(w.y); q[d8 * 8 + 3] = bfhi(w.y); q[d8 * 8 + 4] = bflo(w.z); q[d8 * 8 + 5] = bfhi(w.z); q[d8 * 8 + 6] = bflo(w.w); q[d8 * 8 + 7] = bfhi(w.w); }
#pragma unroll
        for (int d = 0; d < 64; ++d) o[d] = 0.f;
        const int rs0 = min(max(r - 4, 0), 24), cs0 = min(max(qc - 8, 0), 48);
        float mx = -1e30f, l = 0.f;
        for (int kk = 0; kk < 128; ++kk) {
            const int krow = rs0 + (kk >> 4), kcol = cs0 + (kk & 15), kt = b * SEQ + krow * 64 + kcol;
            float s = 0.f;
#pragma unroll
            for (int d8 = 0; d8 < 8; ++d8) { const v4u w = *(const v4u*)(Kb + (size_t)kt * 512 + h * 64 + d8 * 8);
                s += q[d8 * 8 + 0] * bflo(w.x) + q[d8 * 8 + 1] * bfhi(w.x) + q[d8 * 8 + 2] * bflo(w.y) + q[d8 * 8 + 3] * bfhi(w.y) + q[d8 * 8 + 4] * bflo(w.z) + q[d8 * 8 + 5] * bfhi(w.z) + q[d8 * 8 + 6] * bflo(w.w) + q[d8 * 8 + 7] * bfhi(w.w); }
            s += rpb[(h * 15 + (krow - r + 7)) * 31 + (kcol - qc + 15)];
            const float mn = fmaxf(mx, s), scl = __expf(mx - mn), p = __expf(s - mn);
            l = l * scl + p; mx = mn;
#pragma unroll
            for (int d = 0; d < 64; ++d) o[d] = o[d] * scl + p * bf2f(VT[(size_t)(h * 64 + d) * M + kt]);
        }
        const float inv = 1.f / l;
#pragma unroll
        for (int d8 = 0; d8 < 8; ++d8) { v4u w; w.x = pk2(o[d8 * 8] * inv, o[d8 * 8 + 1] * inv); w.y = pk2(o[d8 * 8 + 2] * inv, o[d8 * 8 + 3] * inv); w.z = pk2(o[d8 * 8 + 4] * inv, o[d8 * 8 + 5] * inv); w.w = pk2(o[d8 * 8 + 6] * inv, o[d8 * 8 + 7] * inv);
            *(v4u*)(YNA + (size_t)tok * 512 + h * 64 + d8 * 8) = w; }
    }
}

__device__ __forceinline__ void mixnorm(Frame& F) {
    LAS bf16* T = (LAS bf16*)F.lds; constexpr int TP = 520;
    const bf16* YT = WSP(bf16, WS_YT); const bf16* YNA = WSP(bf16, WS_YNA); bf16* MIX = WSP(bf16, WS_MIX);
    const int tid = F.tid, lane = F.lane, wave = F.wave;
    for (int unit = blockIdx.x; unit < M / 64; unit += F.G) {
        const int tok0 = unit * 64;
        __syncthreads();
#pragma unroll
        for (int it = 0; it < 8; ++it) { const int idx = it * 512 + tid, c = idx >> 3, tg = idx & 7;
            const v4u w = *(const v4u*)(YT + (size_t)c * M + tok0 + tg * 8);
            LAS bf16* d = T + (tg * 8) * TP + c;
            d[0 * TP] = (bf16)(w.x & 0xffff); d[1 * TP] = (bf16)(w.x >> 16); d[2 * TP] = (bf16)(w.y & 0xffff); d[3 * TP] = (bf16)(w.y >> 16);
            d[4 * TP] = (bf16)(w.z & 0xffff); d[5 * TP] = (bf16)(w.z >> 16); d[6 * TP] = (bf16)(w.w & 0xffff); d[7 * TP] = (bf16)(w.w >> 16); }
        __syncthreads();
#pragma unroll
        for (int i = 0; i < 8; ++i) { const int tl = wave * 8 + i, tok = tok0 + tl;
            {   const v4u w = *(const LAS v4u*)(T + tl * TP + lane * 8);
                float v[8] = {bflo(w.x), bfhi(w.x), bflo(w.y), bfhi(w.y), bflo(w.z), bfhi(w.z), bflo(w.w), bfhi(w.w)}; float s = 0.f;
#pragma unroll
                for (int j = 0; j < 8; ++j) s += v[j] * v[j];
                const float r = rsqrtf(wave_sum(s) * (1.0f / HYW) + EPS);
                v4u o; o.x = pk2(v[0] * r, v[1] * r); o.y = pk2(v[2] * r, v[3] * r); o.z = pk2(v[4] * r, v[5] * r); o.w = pk2(v[6] * r, v[7] * r);
                *(v4u*)(MIX + (size_t)tok * DM + lane * 8) = o; }
            {   const v4u w = *(const v4u*)(YNA + (size_t)tok * 512 + lane * 8);
                float v[8] = {bflo(w.x), bfhi(w.x), bflo(w.y), bfhi(w.y), bflo(w.z), bfhi(w.z), bflo(w.w), bfhi(w.w)}; float s = 0.f;
#pragma unroll
                for (int j = 0; j < 8; ++j) s += v[j] * v[j];
                const float r = rsqrtf(wave_sum(s) * (1.0f / NAW) + EPS);
                v4u o; o.x = pk2(v[0] * r, v[1] * r); o.y = pk2(v[2] * r, v[3] * r); o.z = pk2(v[4] * r, v[5] * r); o.w = pk2(v[6] * r, v[7] * r);
                *(v4u*)(MIX + (size_t)tok * DM + 512 + lane * 8) = o; }
        }
    }
}

__device__ __forceinline__ void router_naive(Frame& F) {
    const bf16* H1 = WSP(bf16, WS_H1); const float* WR = WSP(float, WS_WR); float* rs1 = WSP(float, WS_RS1); float* GATE = WSP(float, WS_GATE); int* LIST = WSP(int, WS_LIST);
    const float* bg = F.in[20]; const float* be = F.in[22];
    const int gw = F.vcu * NWAVES + F.wave, NGW = F.G * NWAVES, lane = F.lane;
    for (int tok = gw; tok < M; tok += NGW) {
        const v4u wa = *(const v4u*)(H1 + (size_t)tok * DM + lane * 8), wb = *(const v4u*)(H1 + (size_t)tok * DM + 512 + lane * 8);
        float xv[16] = {bflo(wa.x), bfhi(wa.x), bflo(wa.y), bfhi(wa.y), bflo(wa.z), bfhi(wa.z), bflo(wa.w), bfhi(wa.w), bflo(wb.x), bfhi(wb.x), bflo(wb.y), bfhi(wb.y), bflo(wb.z), bfhi(wb.z), bflo(wb.w), bfhi(wb.w)};
        float ss = 0.f;
#pragma unroll
        for (int i = 0; i < 16; ++i) ss += xv[i] * xv[i];
        const float rstd = rsqrtf(wave_sum(ss) * (1.0f / DM) + EPS);
        if (lane == 0) rs1[tok] = rstd;
        float mylg = 0.f;
#pragma nounroll
        for (int j = 0; j < 36; ++j) {
            const f32x4 w0 = *(const f32x4*)(WR + j * 1024 + lane * 8), w1 = *(const f32x4*)(WR + j * 1024 + lane * 8 + 4), w2 = *(const f32x4*)(WR + j * 1024 + 512 + lane * 8), w3 = *(const f32x4*)(WR + j * 1024 + 512 + lane * 8 + 4);
            float a = xv[0] * w0[0] + xv[1] * w0[1] + xv[2] * w0[2] + xv[3] * w0[3] + xv[4] * w1[0] + xv[5] * w1[1] + xv[6] * w1[2] + xv[7] * w1[3]
                    + xv[8] * w2[0] + xv[9] * w2[1] + xv[10] * w2[2] + xv[11] * w2[3] + xv[12] * w3[0] + xv[13] * w3[1] + xv[14] * w3[2] + xv[15] * w3[3];
            const float sm = wave_sum(a) * rstd + (j < 4 ? bg[j] : be[j - 4]);
            if (lane == j) mylg = sm;
        }
        float lg[4];
#pragma unroll
        for (int j = 0; j < 4; ++j) lg[j] = __shfl(mylg, j);
        int g = 0; float gm = lg[0];
#pragma unroll
        for (int j = 1; j < 4; ++j) if (lg[j] > gm) { gm = lg[j]; g = j; }
        float gz = 0.f;
#pragma unroll
        for (int j = 0; j < 4; ++j) gz += __expf(lg[j] - gm);
        const float g_w = 1.f / gz;
        float e8[8];
#pragma unroll
        for (int i = 0; i < 8; ++i) e8[i] = __shfl(mylg, 4 + g * 8 + i);
        int i0 = 0; float m0 = e8[0];
#pragma unroll
        for (int i = 1; i < 8; ++i) if (e8[i] > m0) { m0 = e8[i]; i0 = i; }
        int i1 = -1; float m1 = -3.0e38f;
#pragma unroll
        for (int i = 0; i < 8; ++i) if (i != i0 && e8[i] > m1) { m1 = e8[i]; i1 = i; }
        const float r = __expf(m1 - m0); const float gate0 = g_w / (1.f + r), gate1 = g_w * r / (1.f + r);
        if (lane == 0) {
            const int e0 = g * 8 + i0, e1 = g * 8 + i1;
            const unsigned s0 = atomicAdd((unsigned*)(F.ctl + CW_CNT + 64 * e0), 1u); LIST[(size_t)e0 * LCAP + s0] = tok * 2; GATE[tok * 2] = gate0;
            const unsigned s1 = atomicAdd((unsigned*)(F.ctl + CW_CNT + 64 * e1), 1u); LIST[(size_t)e1 * LCAP + s1] = tok * 2 + 1; GATE[tok * 2 + 1] = gate1;
        }
    }
}

__device__ __forceinline__ float siluf_(float v) { return v / (1.f + __expf(-v)); }
__device__ __forceinline__ void moe_naive(Frame& F) {
    LAS int* tab = (LAS int*)(F.lds + TAB_OFF);
    LAS float* xs = (LAS float*)F.lds;
    LAS float* hs = xs + 8 * 1024;
    LAS int* tk = (LAS int*)(hs + 8 * 512);
    const bf16* H1 = WSP(bf16, WS_H1); const float* rs1 = WSP(float, WS_RS1); const float* GATE = WSP(float, WS_GATE); const int* LIST = WSP(int, WS_LIST);
    const bf16* W13 = WSP(bf16, WS_W13); const bf16* W2 = WSP(bf16, WS_W2); bf16* YK0 = WSP(bf16, WS_YK0); bf16* YK1 = WSP(bf16, WS_YK1);
    const int tid = F.tid;
    __syncthreads();
    if (tid < NE) tab[40 + tid] = (int)__hip_atomic_load(F.ctl + CW_CNT + 64 * tid, RLX_AGENT);
    __syncthreads();
    if (tid == 0) { int s = 0; for (int e = 0; e < NE; ++e) { tab[e] = s; s += (tab[40 + e] + 7) >> 3; } tab[NE] = s; }
    __syncthreads();
    const int total = tab[NE];
    for (int unit = blockIdx.x; unit < total; unit += F.G) {
        int e = 0;
        for (int j = 1; j < NE; ++j) if (tab[j] <= unit) e = j;
        const int ch = unit - tab[e], ne = tab[40 + e];
        __syncthreads();
        if (tid < 8) { const int idx = ch * 8 + tid; tk[tid] = idx < ne ? LIST[(size_t)e * LCAP + idx] : -1; }
        __syncthreads();
        for (int i = tid; i < 8 * 1024; i += 512) { const int r = i >> 10, k = i & 1023; const int t = tk[r]; xs[i] = t >= 0 ? bf2f(H1[(size_t)(t >> 1) * DM + k]) : 0.f; }
        __syncthreads();
        {
            const int c1 = (tid >> 2) * 8 + (tid & 3);
            const bf16* w1r = W13 + ((size_t)e * 1024 + c1) * DM; const bf16* w3r = w1r + 4 * DM;
            float a1[8], a3[8];
#pragma unroll
            for (int r = 0; r < 8; ++r) { a1[r] = 0.f; a3[r] = 0.f; }
            for (int k8 = 0; k8 < 128; ++k8) {
                const v4u u1 = *(const v4u*)(w1r + k8 * 8), u3 = *(const v4u*)(w3r + k8 * 8);
                const float p1[8] = {bflo(u1.x), bfhi(u1.x), bflo(u1.y), bfhi(u1.y), bflo(u1.z), bfhi(u1.z), bflo(u1.w), bfhi(u1.w)};
                const float p3[8] = {bflo(u3.x), bfhi(u3.x), bflo(u3.y), bfhi(u3.y), bflo(u3.z), bfhi(u3.z), bflo(u3.w), bfhi(u3.w)};
#pragma unroll
                for (int r = 0; r < 8; ++r) { const f32x4 xa = *(const LAS f32x4*)(xs + r * 1024 + k8 * 8), xb = *(const LAS f32x4*)(xs + r * 1024 + k8 * 8 + 4);
                    a1[r] += xa[0] * p1[0] + xa[1] * p1[1] + xa[2] * p1[2] + xa[3] * p1[3] + xb[0] * p1[4] + xb[1] * p1[5] + xb[2] * p1[6] + xb[3] * p1[7];
                    a3[r] += xa[0] * p3[0] + xa[1] * p3[1] + xa[2] * p3[2] + xa[3] * p3[3] + xb[0] * p3[4] + xb[1] * p3[5] + xb[2] * p3[6] + xb[3] * p3[7]; }
            }
#pragma unroll
            for (int r = 0; r < 8; ++r) { const int t = tk[r]; const float rs = t >= 0 ? rs1[t >> 1] : 0.f; hs[r * 512 + tid] = bfr(siluf_(a1[r] * rs) * (a3[r] * rs)); }
        }
        __syncthreads();
#pragma unroll
        for (int cc = 0; cc < 2; ++cc) { const int c = tid * 2 + cc; const bf16* w2r = W2 + ((size_t)e * DM + c) * DE;
            float a[8];
#pragma unroll
            for (int r = 0; r < 8; ++r) a[r] = 0.f;
            for (int k8 = 0; k8 < 64; ++k8) { const v4u u = *(const v4u*)(w2r + k8 * 8);
                const float p[8] = {bflo(u.x), bfhi(u.x), bflo(u.y), bfhi(u.y), bflo(u.z), bfhi(u.z), bflo(u.w), bfhi(u.w)};
#pragma unroll
                for (int r = 0; r < 8; ++r) { const f32x4 xa = *(const LAS f32x4*)(hs + r * 512 + k8 * 8), xb = *(const LAS f32x4*)(hs + r * 512 + k8 * 8 + 4);
                    a[r] += xa[0] * p[0] + xa[1] * p[1] + xa[2] * p[2] + xa[3] * p[3] + xb[0] * p[4] + xb[1] * p[5] + xb[2] * p[6] + xb[3] * p[7]; } }
#pragma unroll
            for (int r = 0; r < 8; ++r) { const int t = tk[r]; if (t >= 0) { bf16* Y = (t & 1) ? YK1 : YK0; Y[(size_t)(t >> 1) * DM + c] = (bf16)f2bf(a[r] * GATE[t]); } }
        }
    }
}

__device__ __forceinline__ void combine(Frame& F) {
    const bf16* H1 = WSP(bf16, WS_H1); const bf16* Y0 = WSP(bf16, WS_YK0); const bf16* Y1 = WSP(bf16, WS_YK1); bf16* H2 = WSP(bf16, WS_H2); float* rs2 = WSP(float, WS_RS2);
    const int gw = F.vcu * NWAVES + F.wave, NGW = F.G * NWAVES, lane = F.lane;
    for (int tok = gw; tok < M; tok += NGW) {
        float ss = 0.f;
#pragma unroll
        for (int hh = 0; hh < 2; ++hh) { const size_t o = (size_t)tok * DM + hh * 512 + lane * 8;
            const v4u a = *(const v4u*)(H1 + o), b = *(const v4u*)(Y0 + o), c = *(const v4u*)(Y1 + o);
            float v[8] = {bflo(a.x) + bflo(b.x) + bflo(c.x), bfhi(a.x) + bfhi(b.x) + bfhi(c.x), bflo(a.y) + bflo(b.y) + bflo(c.y), bfhi(a.y) + bfhi(b.y) + bfhi(c.y),
                          bflo(a.z) + bflo(b.z) + bflo(c.z), bfhi(a.z) + bfhi(b.z) + bfhi(c.z), bflo(a.w) + bflo(b.w) + bflo(c.w), bfhi(a.w) + bfhi(b.w) + bfhi(c.w)};
            v4u w; w.x = pk2(v[0], v[1]); w.y = pk2(v[2], v[3]); w.z = pk2(v[4], v[5]); w.w = pk2(v[6], v[7]);
            *(v4u*)(H2 + o) = w;
            const float q[8] = {bflo(w.x), bfhi(w.x), bflo(w.y), bfhi(w.y), bflo(w.z), bfhi(w.z), bflo(w.w), bfhi(w.w)};
#pragma unroll
            for (int j = 0; j < 8; ++j) ss += q[j] * q[j]; }
        ss = wave_sum(ss);
        if (lane == 0) rs2[tok] = rsqrtf(ss * (1.0f / DM) + EPS);
    }
}
__device__ __forceinline__ void final_norm(Frame& F) {
    const bf16* H3 = WSP(bf16, WS_H3); const float* gf = F.in[29]; float* out = F.out;
    const int gw = F.vcu * NWAVES + F.wave, NGW = F.G * NWAVES, lane = F.lane;
    for (int tok = gw; tok < M; tok += NGW) {
        float v[16]; float ss = 0.f;
#pragma unroll
        for (int hh = 0; hh < 2; ++hh) { const v4u a = *(const v4u*)(H3 + (size_t)tok * DM + hh * 512 + lane * 8);
            v[hh * 8 + 0] = bflo(a.x); v[hh * 8 + 1] = bfhi(a.x); v[hh * 8 + 2] = bflo(a.y); v[hh * 8 + 3] = bfhi(a.y); v[hh * 8 + 4] = bflo(a.z); v[hh * 8 + 5] = bfhi(a.z); v[hh * 8 + 6] = bflo(a.w); v[hh * 8 + 7] = bfhi(a.w); }
#pragma unroll
        for (int j = 0; j < 16; ++j) ss += v[j] * v[j];
        const float r = rsqrtf(wave_sum(ss) * (1.0f / DM) + EPS);
#pragma unroll
        for (int hh = 0; hh < 2; ++hh) { const int c0 = hh * 512 + lane * 8; const f32x4 g0 = *(const f32x4*)(gf + c0), g1 = *(const f32x4*)(gf + c0 + 4);
            f32x4 o0 = {v[hh * 8 + 0] * r * g0[0], v[hh * 8 + 1] * r * g0[1], v[hh * 8 + 2] * r * g0[2], v[hh * 8 + 3] * r * g0[3]};
            f32x4 o1 = {v[hh * 8 + 4] * r * g1[0], v[hh * 8 + 5] * r * g1[1], v[hh * 8 + 6] * r * g1[2], v[hh * 8 + 7] * r * g1[3]};
            *(f32x4*)(out + (size_t)tok * DM + c0) = o0; *(f32x4*)(out + (size_t)tok * DM + c0 + 4) = o1; }
    }
}
typedef float f32x16 __attribute__((ext_vector_type(16)));
constexpr size_t WS_WRB = WS_WR + 160 * KiB;

__device__ __forceinline__ void p0_router_weights_bf16(Frame& F) {
    bf16* WRB = WSP(bf16, WS_WRB); const float* g_ffn = F.in[18];
    for (int i = blockIdx.x * 512 + F.tid; i < 48 * 1024; i += F.G * 512) { const int w = i >> 10, k = i & 1023, nt = w >> 4, g = (w >> 2) & 3, reg = w & 3;
        const float v = (nt < 2 ? F.in[21][k * 32 + g * 8 + 4 * nt + reg] : F.in[19][k * 4 + reg]) * g_ffn[k];
        WRB[i] = (bf16)f2bf(v); }
}
__device__ __forceinline__ void router_mfma(Frame& F) {
    const bf16* H1 = WSP(bf16, WS_H1); const bf16* WRB = WSP(bf16, WS_WRB); float* rs1 = WSP(float, WS_RS1); float* GATE = WSP(float, WS_GATE); int* LIST = WSP(int, WS_LIST);
    const float* bg = F.in[20]; const float* be = F.in[22];
    LAS int* lcnt = (LAS int*)(F.lds + TAB_OFF); LAS int* lbase = lcnt + 32;
    const int lane = F.lane, j = lane & 15, g = lane >> 4;
    const int ntask = M / 16, per = F.G * NWAVES, niter = (ntask + per - 1) / per;
    for (int it = 0; it < niter; ++it) {
        const int task = (it * F.G + blockIdx.x) * NWAVES + F.wave; const bool live = task < ntask;
        __syncthreads();
        if (F.tid < 32) lcnt[F.tid] = 0;
        __syncthreads();
        int e0 = 0, e1 = 0, r0 = 0, r1 = 0, tok = 0; float gate0 = 0.f, gate1 = 0.f; bool mine = false;
        if (live) {
            tok = task * 16 + j;
            const bf16* hrow = H1 + (size_t)tok * DM + 8 * g; const bf16* wrow = WRB + (size_t)j * DM + 8 * g;
            f32x4 acc[3] = {{0.f, 0.f, 0.f, 0.f}, {0.f, 0.f, 0.f, 0.f}, {0.f, 0.f, 0.f, 0.f}}; float ss = 0.f;
#pragma unroll 4
            for (int kk = 0; kk < 32; ++kk) {
                const v4u hb = *(const v4u*)(hrow + 32 * kk);
                const bf16x8 bfrag = __builtin_bit_cast(bf16x8, hb);
                ss += bflo(hb.x) * bflo(hb.x) + bfhi(hb.x) * bfhi(hb.x) + bflo(hb.y) * bflo(hb.y) + bfhi(hb.y) * bfhi(hb.y) + bflo(hb.z) * bflo(hb.z) + bfhi(hb.z) * bfhi(hb.z) + bflo(hb.w) * bflo(hb.w) + bfhi(hb.w) * bfhi(hb.w);
#pragma unroll
                for (int nt = 0; nt < 3; ++nt) { const bf16x8 afrag = *(const bf16x8*)(wrow + (size_t)nt * 16 * DM + 32 * kk);
                    acc[nt] = __builtin_amdgcn_mfma_f32_16x16x32_bf16(afrag, bfrag, acc[nt], 0, 0, 0); }
            }
            ss += __shfl_xor(ss, 16); ss += __shfl_xor(ss, 32);
            const float rstd = rsqrtf(ss * (1.0f / DM) + EPS);
            if (g == 0) rs1[tok] = rstd;
            float gl[4], e8[8];
#pragma unroll
            for (int r = 0; r < 4; ++r) { gl[r] = acc[2][r] * rstd + bg[r]; e8[r] = acc[0][r] * rstd + be[g * 8 + r]; e8[4 + r] = acc[1][r] * rstd + be[g * 8 + 4 + r]; }
            int gs = 0; float gm = gl[0];
#pragma unroll
            for (int r = 1; r < 4; ++r) if (gl[r] > gm) { gm = gl[r]; gs = r; }
            float gz = 0.f;
#pragma unroll
            for (int r = 0; r < 4; ++r) gz += __expf(gl[r] - gm);
            const float g_w = 1.f / gz;
            int i0 = 0; float m0 = e8[0];
#pragma unroll
            for (int i = 1; i < 8; ++i) if (e8[i] > m0) { m0 = e8[i]; i0 = i; }
            int i1 = -1; float m1 = -3.0e38f;
#pragma unroll
            for (int i = 0; i < 8; ++i) if (i != i0 && e8[i] > m1) { m1 = e8[i]; i1 = i; }
            const float rr = __expf(m1 - m0); gate0 = g_w / (1.f + rr); gate1 = g_w * rr / (1.f + rr);
            mine = (g == gs); e0 = g * 8 + i0; e1 = g * 8 + i1;
            if (mine) { r0 = __hip_atomic_fetch_add(lcnt + e0, 1, __ATOMIC_RELAXED, __HIP_MEMORY_SCOPE_WORKGROUP); r1 = __hip_atomic_fetch_add(lcnt + e1, 1, __ATOMIC_RELAXED, __HIP_MEMORY_SCOPE_WORKGROUP); }
        }
        __syncthreads();
        if (F.tid < 32) { const int n = lcnt[F.tid]; lbase[F.tid] = n > 0 ? (int)atomicAdd((unsigned*)(F.ctl + CW_CNT + 64 * F.tid), (unsigned)n) : 0; }
        __syncthreads();
        if (mine) {
            LIST[(size_t)e0 * LCAP + lbase[e0] + r0] = tok * 2; GATE[tok * 2] = gate0;
            LIST[(size_t)e1 * LCAP + lbase[e1] + r1] = tok * 2 + 1; GATE[tok * 2 + 1] = gate1;
        }
    }
}

__device__ __forceinline__ void moe_table(Frame& F, LAS int* tab) {
    __syncthreads();
    if (F.tid < NE) tab[40 + F.tid] = (int)__hip_atomic_load(F.ctl + CW_CNT + 64 * F.tid, RLX_AGENT);
    __syncthreads();
    if (F.tid == 0) { int s = 0; for (int e = 0; e < NE; ++e) { tab[e] = s; s += (tab[40 + e] + 255) >> 8; } tab[NE] = s; }
    __syncthreads();
}
template <bool GATHER>
struct MoeSrc {
    const LAS int* tab; int G, c, ntiles, K;
    const char* A; const char* B; size_t estepB, tstepB, tstepA; const int* LIST;
    __device__ __forceinline__ bool next(int i, pg8::Unit& u) const {
        const int L = i * G + c; if (L >= ntiles * 4) return false;
        const int tile = L >> 2; int e = 0;
        for (int jj = 1; jj < NE; ++jj) if (tab[jj] <= tile) e = jj;
        e = __builtin_amdgcn_readfirstlane(e);
        u.pm = tile; u.pn = L & 3; u.e = e; u.aux = tile - __builtin_amdgcn_readfirstlane(tab[e]); return true;
    }
    __device__ __forceinline__ const char* abase(const pg8::Unit& u) const { return GATHER ? A : A + (size_t)u.pm * tstepA; }
    __device__ __forceinline__ const char* bbase(const pg8::Unit& u) const { return B + (size_t)u.e * estepB + (size_t)u.pn * tstepB; }
    __device__ __forceinline__ void aoff(const pg8::Unit& u, int K_, const int (&R)[2], const int (&C)[2], unsigned (&off)[2][2]) const {
        if constexpr (GATHER) {
            const int ne = tab[40 + u.e]; const int* lst = LIST + (size_t)u.e * LCAP;
#pragma unroll
            for (int h = 0; h < 2; ++h)
#pragma unroll
                for (int i = 0; i < 2; ++i) { const int r = u.aux * 256 + 128 * h + R[i]; const int t = lst[r < ne ? r : 0];
                    off[h][i] = (unsigned)(t >> 1) * (unsigned)(K_ * 2) + (unsigned)C[i] * 2u; }
        } else {
#pragma unroll
            for (int h = 0; h < 2; ++h)
#pragma unroll
                for (int i = 0; i < 2; ++i) off[h][i] = (unsigned)((128 * h + R[i]) * K_ + C[i]) * 2u;
        }
    }
};
struct EpiM1 {
    static constexpr bool PERM = true;
    bf16* HID; const int* LIST; const float* rs1; const LAS int* tab;
    __device__ __forceinline__ void operator()(const f32x4 (&acc)[2][2][4][2], const Unit& u, int wr, int wc, int fr, int fq) const {
        const int ne = tab[40 + u.e]; const int* lst = LIST + (size_t)u.e * LCAP;
        const int hc0 = u.pn * 128 + wc * 16 + 4 * fq;
#pragma unroll
        for (int ai = 0; ai < 2; ++ai)
#pragma unroll
            for (int m = 0; m < 4; ++m) { const int rl = ai * 128 + wr * 64 + m * 16 + fr, r = u.aux * 256 + rl;
                float rs = 0.f; if (r < ne) rs = rs1[lst[r] >> 1];
                bf16* rowp = HID + (size_t)(u.pm * 256 + rl) * DE + hc0;
#pragma unroll
                for (int bj = 0; bj < 2; ++bj) { const f32x4 a1 = acc[ai][bj][m][0] * rs, a3 = acc[ai][bj][m][1] * rs;
                    float hv[4];
#pragma unroll
                    for (int i = 0; i < 4; ++i) hv[i] = a1[i] / (1.f + __expf(-a1[i])) * a3[i];
                    v2u w; w.x = pg8::cvt_pk_bf16(hv[0], hv[1]); w.y = pg8::cvt_pk_bf16(hv[2], hv[3]);
                    *(v2u*)(rowp + bj * 64) = w; } }
    }
};
struct EpiM2 {
    static constexpr bool PERM = true;
    bf16* Y0; long ydelta; const int* LIST; const float* GATE; const LAS int* tab;
    __device__ __forceinline__ void operator()(const f32x4 (&acc)[2][2][4][2], const Unit& u, int wr, int wc, int fr, int fq) const {
        const int ne = tab[40 + u.e]; const int* lst = LIST + (size_t)u.e * LCAP;
        const int col0 = u.pn * 256 + wc * 32 + 8 * fq;
#pragma unroll
        for (int ai = 0; ai < 2; ++ai)
#pragma unroll
            for (int m = 0; m < 4; ++m) { const int r = u.aux * 256 + ai * 128 + wr * 64 + m * 16 + fr;
                if (r < ne) { const int t = lst[r]; const float gt = GATE[t]; bf16* rowp = Y0 + (long)(t & 1) * ydelta + (size_t)(t >> 1) * DM + col0;
#pragma unroll
                    for (int bj = 0; bj < 2; ++bj) { const f32x4 v0 = acc[ai][bj][m][0] * gt, v1 = acc[ai][bj][m][1] * gt;
                        v4u w; w.x = pg8::cvt_pk_bf16(v0[0], v0[1]); w.y = pg8::cvt_pk_bf16(v0[2], v0[3]); w.z = pg8::cvt_pk_bf16(v1[0], v1[1]); w.w = pg8::cvt_pk_bf16(v1[2], v1[3]);
                        *(v4u*)(rowp + bj * 128) = w; } } }
    }
};
#ifndef PG8_SP2
#define PG8_SP2 true
#endif
#ifndef PG8_ALIGN
#define PG8_ALIGN true
#endif
__device__ __forceinline__ void moe_gemm1(Frame& F) {
    LAS int* tab = (LAS int*)(F.lds + TAB_OFF);
    moe_table(F, tab);
    MoeSrc<true> S; S.tab = tab; S.G = F.G; S.c = (int)blockIdx.x; S.ntiles = __builtin_amdgcn_readfirstlane(tab[NE]); S.K = DM;
    S.A = (const char*)WSP(bf16, WS_H1); S.B = (const char*)WSP(bf16, WS_W13); S.estepB = (size_t)1024 * DM * 2; S.tstepB = (size_t)256 * DM * 2; S.tstepA = 0; S.LIST = WSP(int, WS_LIST);
    EpiM1 E{WSP(bf16, WS_HID), WSP(int, WS_LIST), WSP(float, WS_RS1), tab};
    pg8::gemm_phase<EpiM1, MoeSrc<true>, true, true, PG8_ALIGN, PG8_SP2>(F.lds + RING_OFF, DM, S, E);
}
__device__ __forceinline__ void moe_gemm2(Frame& F) {
    LAS int* tab = (LAS int*)(F.lds + TAB_OFF);
    moe_table(F, tab);
    MoeSrc<false> S; S.tab = tab; S.G = F.G; S.c = (int)blockIdx.x; S.ntiles = __builtin_amdgcn_readfirstlane(tab[NE]); S.K = DE;
    S.A = (const char*)WSP(bf16, WS_HID); S.B = (const char*)WSP(bf16, WS_W2); S.estepB = (size_t)DM * DE * 2; S.tstepB = (size_t)256 * DE * 2; S.tstepA = (size_t)256 * DE * 2; S.LIST = WSP(int, WS_LIST);
    EpiM2 E{WSP(bf16, WS_YK0), (long)((WS_YK1 - WS_YK0) / 2), WSP(int, WS_LIST), WSP(float, WS_GATE), tab};
    pg8::gemm_phase<EpiM2, MoeSrc<false>, true, false, PG8_ALIGN, PG8_SP2>(F.lds + RING_OFF, DE, S, E);
}

__device__ __forceinline__ void hyena_mfma(Frame& F) {
    constexpr int ZP = 4112, CP = 8208, GC_OFF = 16 * ZP;
    static_assert(GC_OFF + 8 * CP <= SCRATCH_BYTES, "hyena LDS");
    LAS unsigned char* ZB = F.lds; LAS unsigned char* GC = F.lds + GC_OFF;
    const bf16* UT = WSP(bf16, WS_UT); const bf16* HYK = WSP(bf16, WS_HYK); bf16* YT = WSP(bf16, WS_YT);
    const float* cw = F.in[4]; const float* cbv = F.in[5]; const float* skip = F.in[13];
    const int tid = F.tid, lane = F.lane, w = F.wave, r = lane & 15, g = lane >> 4;
    const int rho_l = (8 - (r & 7)) & 7;
    const int abase = rho_l * CP + (2048 - r + 8 * g - rho_l) * 2 - 512 * w;
    const int bbase = r * ZP + 16 * g;
    for (int c = blockIdx.x; c < HYW; c += F.G) {
        __syncthreads();
        {
            const float w0 = cw[1024 + c], w1 = cw[1536 + 1024 + c], w2 = cw[3072 + 1024 + c], cb = cbv[1024 + c];
#pragma unroll
            for (int it = 0; it < 8; ++it) { const int idx = it * 512 + tid, b = idx >> 8, s0 = (idx & 255) * 8;
                const bf16* u = UT + (size_t)(1024 + c) * M + b * SEQ;
                const v4u x8 = *(const v4u*)(u + s0);
                float x[10]; x[0] = s0 > 0 ? bf2f(u[s0 - 1]) : 0.f; x[9] = s0 + 8 < SEQ ? bf2f(u[s0 + 8]) : 0.f;
                x[1] = bflo(x8.x); x[2] = bfhi(x8.x); x[3] = bflo(x8.y); x[4] = bfhi(x8.y); x[5] = bflo(x8.z); x[6] = bfhi(x8.z); x[7] = bflo(x8.w); x[8] = bfhi(x8.w);
                float o8[8];
#pragma unroll
                for (int i = 0; i < 8; ++i) o8[i] = cb + w0 * x[i] + w1 * x[i + 1] + w2 * x[i + 2];
                v4u o; o.x = pk2(o8[0], o8[1]); o.y = pk2(o8[2], o8[3]); o.z = pk2(o8[4], o8[5]); o.w = pk2(o8[6], o8[7]);
                *(LAS v4u*)(ZB + b * ZP + s0 * 2) = o; }
        }
#pragma nounroll
        for (int o = 0; o < 2; ++o) {
            {
                const bf16* Gsrc = HYK + (size_t)(o * 512 + c) * GSTR;
                const v4u lo = *(const v4u*)(Gsrc + 8 * tid), hi = *(const v4u*)(Gsrc + 8 * tid + 8);
                const unsigned d[8] = {lo.x, lo.y, lo.z, lo.w, hi.x, hi.y, hi.z, hi.w};
#pragma unroll
                for (int rho = 0; rho < 8; ++rho) { const int j = rho >> 1; v4u q;
                    if (rho & 1) { q.x = (d[j] >> 16) | (d[j + 1] << 16); q.y = (d[j + 1] >> 16) | (d[j + 2] << 16); q.z = (d[j + 2] >> 16) | (d[j + 3] << 16); q.w = (d[j + 3] >> 16) | (d[j + 4] << 16); }
                    else { q.x = d[j]; q.y = d[j + 1]; q.z = d[j + 2]; q.w = d[j + 3]; }
                    *(LAS v4u*)(GC + rho * CP + tid * 16) = q; }
            }
            __syncthreads();
            f32x4 acc[16]; bf16x8 W[16];
#pragma unroll
            for (int i = 0; i < 16; ++i) { acc[i] = (f32x4){0.f, 0.f, 0.f, 0.f}; W[i] = *(const LAS bf16x8*)(GC + abase - 32 * i); }
            bf16x8 bcur = *(const LAS bf16x8*)(ZB + bbase);
#pragma nounroll
            for (int jo = 0; jo < 8; ++jo) {
#pragma unroll
                for (int jj = 0; jj < 8; ++jj) {
                    const int J = jo * 8 + jj, Jn = J < 63 ? J + 1 : 63;
                    const bf16x8 bnext = *(const LAS bf16x8*)(ZB + bbase + 64 * Jn);
#pragma unroll
                    for (int i = 0; i < 16; ++i) { const int I = (i + 14) & 15;
                        acc[I] = __builtin_amdgcn_mfma_f32_16x16x32_bf16(W[(I - 2 * jj) & 15], bcur, acc[I], 0, 0, 0); }
                    W[(-2 * (jj + 1)) & 15] = *(const LAS bf16x8*)(GC + abase + 64 * Jn);
                    W[(-2 * (jj + 1) + 1) & 15] = *(const LAS bf16x8*)(GC + abase + 64 * Jn - 32);
                    bcur = bnext;
                }
            }
            __syncthreads();
            {
                const int gc = o ? 512 + c : c; const float w0 = cw[gc], w1 = cw[1536 + gc], w2 = cw[3072 + gc], cb = cbv[gc], sk = skip[o * 512 + c];
                const bf16* u = UT + (size_t)gc * M + r * SEQ;
#pragma unroll
                for (int I = 0; I < 16; ++I) { const int t0 = 256 * w + 16 * I + 4 * g;
                    const v2u zo = *(const LAS v2u*)(ZB + r * ZP + t0 * 2);
                    const v2u x4 = *(const v2u*)(u + t0);
                    float x[6]; x[0] = t0 > 0 ? bf2f(u[t0 - 1]) : 0.f; x[5] = t0 + 4 < SEQ ? bf2f(u[t0 + 4]) : 0.f;
                    x[1] = bflo(x4.x); x[2] = bfhi(x4.x); x[3] = bflo(x4.y); x[4] = bfhi(x4.y);
                    const float zz[4] = {bflo(zo.x), bfhi(zo.x), bflo(zo.y), bfhi(zo.y)};
                    float ov[4];
#pragma unroll
                    for (int i = 0; i < 4; ++i) ov[i] = (cb + w0 * x[i] + w1 * x[i + 1] + w2 * x[i + 2]) * (acc[I][i] + zz[i] * sk);
                    v2u q; q.x = pk2(ov[0], ov[1]); q.y = pk2(ov[2], ov[3]);
                    if (o == 0) *(LAS v2u*)(ZB + r * ZP + t0 * 2) = q;
                    else *(v2u*)(YT + (size_t)c * M + r * SEQ + t0) = q; }
            }
        }
    }
}

__device__ __forceinline__ void natten_mfma(Frame& F) {
    LAS float* RPB = (LAS float*)F.lds;
    const bf16* Q = WSP(bf16, WS_Q); const bf16* Kb = WSP(bf16, WS_K); const bf16* VT = WSP(bf16, WS_UT) + (size_t)1536 * M; bf16* YNA = WSP(bf16, WS_YNA);
    __syncthreads();
    for (int i = F.tid; i < NH * 15 * 31; i += 512) RPB[i] = F.in[14][i];
    __syncthreads();
    const int lane = F.lane, ql = lane & 31, hf = lane >> 5, head = F.wave;
    for (int unit = blockIdx.x; unit < NB * 16; unit += F.G) {
        const int b = unit >> 4, p = unit & 15;
        const int kr0 = min(min(max(2 * p - 4, 0), 24), 23);
#pragma nounroll
        for (int j = 0; j < 4; ++j) {
            const int kc0 = j == 0 ? 0 : (j == 1 ? 8 : (j == 2 ? 24 : 32));
            const int qrow = 2 * p + (ql >> 4), qcol = 16 * j + (ql & 15), tq = b * SEQ + qrow * 64 + qcol;
            const int rsq = min(max(qrow - 4, 0), 24), csq = min(max(qcol - 8, 0), 48);
            bf16x8 qf[4];
#pragma unroll
            for (int s = 0; s < 4; ++s) qf[s] = *(const bf16x8*)(Q + (size_t)tq * 512 + head * 64 + 16 * s + 8 * hf);
            f32x16 O[2];
#pragma unroll
            for (int dt = 0; dt < 2; ++dt) O[dt] = (f32x16){0.f, 0.f, 0.f, 0.f, 0.f, 0.f, 0.f, 0.f, 0.f, 0.f, 0.f, 0.f, 0.f, 0.f, 0.f, 0.f};
            float mx = -1e30f, l = 0.f;
#pragma unroll
            for (int i = 0; i < 9; ++i) {
                const int krow = kr0 + i, kt = b * SEQ + krow * 64 + kc0 + ql;
                f32x16 a = {0.f, 0.f, 0.f, 0.f, 0.f, 0.f, 0.f, 0.f, 0.f, 0.f, 0.f, 0.f, 0.f, 0.f, 0.f, 0.f};
#pragma unroll
                for (int s = 0; s < 4; ++s) { const bf16x8 kf = *(const bf16x8*)(Kb + (size_t)kt * 512 + head * 64 + 16 * s + 8 * hf);
                    a = __builtin_amdgcn_mfma_f32_32x32x16_bf16(kf, qf[s], a, 0, 0, 0); }
                const bool rv = krow >= rsq && krow < rsq + 8; const int dr = krow - qrow + 7;
                float tm = -3.0e38f;
#pragma unroll
                for (int rg = 0; rg < 16; ++rg) { const int kcol = kc0 + (rg & 3) + 8 * (rg >> 2) + 4 * hf; const bool v = rv && kcol >= csq && kcol < csq + 16;
                    const int bi = v ? (head * 15 + dr) * 31 + (kcol - qcol + 15) : 0;
                    const float sv = v ? a[rg] + RPB[bi] : -3.0e38f;
                    a[rg] = sv; tm = fmaxf(tm, sv); }
                tm = fmaxf(tm, __shfl_xor(tm, 32));
                const float mn = fmaxf(mx, tm), alpha = __expf(mx - mn); mx = mn;
                float ls = 0.f;
#pragma unroll
                for (int rg = 0; rg < 16; ++rg) { const float pv = __expf(a[rg] - mn); a[rg] = pv; ls += pv; }
                l = l * alpha + ls;
#pragma unroll
                for (int dt = 0; dt < 2; ++dt) O[dt] = O[dt] * alpha;
#pragma unroll
                for (int s = 0; s < 2; ++s) {
                    v4u pw; pw.x = pg8::cvt_pk_bf16(a[8 * s + 0], a[8 * s + 1]); pw.y = pg8::cvt_pk_bf16(a[8 * s + 2], a[8 * s + 3]);
                    pw.z = pg8::cvt_pk_bf16(a[8 * s + 4], a[8 * s + 5]); pw.w = pg8::cvt_pk_bf16(a[8 * s + 6], a[8 * s + 7]);
                    const bf16x8 pf = __builtin_bit_cast(bf16x8, pw);
#pragma unroll
                    for (int dt = 0; dt < 2; ++dt) { const bf16* vrow = VT + (size_t)(head * 64 + dt * 32 + ql) * M + b * SEQ + krow * 64 + kc0 + 16 * s + 4 * hf;
                        const v2u v0 = *(const v2u*)vrow, v1 = *(const v2u*)(vrow + 8);
                        v4u vw; vw.x = v0.x; vw.y = v0.y; vw.z = v1.x; vw.w = v1.y;
                        O[dt] = __builtin_amdgcn_mfma_f32_32x32x16_bf16(__builtin_bit_cast(bf16x8, vw), pf, O[dt], 0, 0, 0); }
                }
            }
            l += __shfl_xor(l, 32);
            const float inv = 1.f / l;
#pragma unroll
            for (int dt = 0; dt < 2; ++dt)
#pragma unroll
                for (int g4 = 0; g4 < 4; ++g4) { v2u w; w.x = pg8::cvt_pk_bf16(O[dt][4 * g4] * inv, O[dt][4 * g4 + 1] * inv); w.y = pg8::cvt_pk_bf16(O[dt][4 * g4 + 2] * inv, O[dt][4 * g4 + 3] * inv);
                    *(v2u*)(YNA + (size_t)tq * 512 + head * 64 + 32 * dt + 8 * g4 + 4 * hf) = w; }
        }
    }
}
__device__ __forceinline__ void hyena_phase(Frame& F) {
#if HY_NAIVE
    hyena_naive(F);
#else
    hyena_mfma(F);
#endif
}
__device__ __forceinline__ void natten_phase(Frame& F) {
#if NA_NAIVE
    natten_naive(F);
#else
    natten_mfma(F);
#endif
}
__device__ __forceinline__ void router_phase(Frame& F) {
#if RT_NAIVE
    router_naive(F);
#else
    router_mfma(F);
#endif
}
__device__ __forceinline__ void moe_phase_a(Frame& F) {
#if MOE_NAIVE
    moe_naive(F);
#else
    moe_gemm1(F);
#endif
}
__device__ __forceinline__ void moe_phase_b(Frame& F) {
#if MOE_NAIVE
    (void)F;
#else
    moe_gemm2(F);
#endif
}
constexpr int N_PHASES = 11;
constexpr int N_LAUNCHES = MK_N_LAUNCHES;
struct Args { const float* in[30]; float* out; unsigned char* ws; int ph_lo, ph_hi; };
#ifndef PG8_SP2
#define PG8_SP2 true
#endif
#ifndef PG8_ALIGN
#define PG8_ALIGN true
#endif
__global__ void __launch_bounds__(NWAVES * 64, 2) fwd_kernel(Args args) {
    extern __shared__ __attribute__((aligned(16))) unsigned char lds[];
    Frame F;
    F.lds = (LAS unsigned char*)lds;
    F.MISC = (volatile LAS unsigned*)(F.lds + MISC_OFF);
    F.tid = threadIdx.x; F.lane = F.tid & 63; F.wave = __builtin_amdgcn_readfirstlane(F.tid >> 6);
    F.G = gridDim.x; { const int bx = blockIdx.x; F.vcu = (F.G % 8 == 0) ? (bx % 8) * (F.G / 8) + bx / 8 : bx; }
    F.ws = args.ws; F.in = args.in; F.out = args.out;
    F.ctl = (gu32*)(F.ws + WS_CTL);
    for (int u = F.tid; u < (LDS_BYTES - LDSCTL_OFF) / 4; u += NWAVES * 64) ((LAS unsigned*)(F.lds + LDSCTL_OFF))[u] = 0u;
    __syncthreads();
    XcdBarrier bar; bar.bar = (unsigned*)(F.ctl + CW_BAR); bar.x = 0; bar.st = nullptr;
    if (N_LAUNCHES == 1) bar = xcd_barrier_post((unsigned*)(F.ctl + CW_BAR), F.MISC + 8);
#define GRID_BAR() do { if (N_LAUNCHES == 1) xcd_barrier(bar); } while (0)
    const int lo = args.ph_lo, hi = args.ph_hi;
#ifndef PH_MASK
#define PH_MASK 0xFFFF
#endif
#define IN(k) (((PH_MASK >> (k)) & 1) && lo <= (k) && (k) < hi)
#define BOTH(k) (IN(k) && IN((k) + 1))

    if (IN(0)) { p0_prologue(F); p0_router_weights_bf16(F); if (BOTH(0)) GRID_BAR(); }

    if (IN(1)) {
        { DenseSrc S; S.set(WSP(bf16, WS_XB), WSP(bf16, WS_WIN), M, UTR, DM, F.G, (int)blockIdx.x);
          EpiUT E{WSP(bf16, WS_UT), WSP(float, WS_RSX)};
          pg8::gemm_phase<EpiUT, DenseSrc, false, false, PG8_ALIGN, PG8_SP2>(F.lds + RING_OFF, DM, S, E); }
        { DenseSrc S; S.set(WSP(bf16, WS_XB), WSP(bf16, WS_WIN) + (size_t)UTR * DM, M, 1024, DM, F.G, (int)blockIdx.x);
          EpiQK E{WSP(bf16, WS_Q), WSP(bf16, WS_K), WSP(float, WS_RSX)};
          pg8::gemm_phase<EpiQK, DenseSrc, true, false, PG8_ALIGN, PG8_SP2>(F.lds + RING_OFF, DM, S, E); }
        if (BOTH(1)) GRID_BAR();
    }

    if (IN(2)) { hyena_phase(F); __syncthreads(); natten_phase(F); if (BOTH(2)) GRID_BAR(); }

    if (IN(3)) { mixnorm(F); if (BOTH(3)) GRID_BAR(); }

    if (IN(4)) {
        DenseSrc S; S.set(WSP(bf16, WS_MIX), WSP(bf16, WS_WOUT), M, DM, DM, F.G, (int)blockIdx.x);
        EpiH1 E{WSP(bf16, WS_H1), F.in[0]};
        pg8::gemm_phase<EpiH1, DenseSrc, true, false, PG8_ALIGN, PG8_SP2>(F.lds + RING_OFF, DM, S, E);
        if (BOTH(4)) GRID_BAR();
    }

    if (IN(5)) { router_phase(F); if (BOTH(5)) GRID_BAR(); }

    if (IN(6)) { moe_phase_a(F); if (BOTH(6)) GRID_BAR(); }

    if (IN(7)) { moe_phase_b(F); if (BOTH(7)) GRID_BAR(); }

    if (IN(8)) {
        combine(F);
        __syncthreads();
        DenseSrc S; S.set(WSP(bf16, WS_PB), WSP(bf16, WS_WP), M, DM, PLE, F.G, (int)blockIdx.x);
        EpiPL E{WSP(bf16, WS_PL)};
        pg8::gemm_phase<EpiPL, DenseSrc, true, false, PG8_ALIGN, PG8_SP2>(F.lds + RING_OFF, PLE, S, E);
        if (BOTH(8)) GRID_BAR();
    }

    if (IN(9)) {
        DenseSrc S; S.set(WSP(bf16, WS_H2), WSP(bf16, WS_WG), M, DM, DM, F.G, (int)blockIdx.x);
        EpiPLE E{WSP(bf16, WS_H3), WSP(bf16, WS_H2), WSP(bf16, WS_PL), WSP(float, WS_RS2)};
        pg8::gemm_phase<EpiPLE, DenseSrc, true, false, PG8_ALIGN, PG8_SP2>(F.lds + RING_OFF, DM, S, E);
        if (BOTH(9)) GRID_BAR();
    }

    if (IN(10)) { final_norm(F); }
#undef IN
#undef BOTH
}

extern "C" void kernel_launch(void* const* d_in, const int* in_sizes, int n_in, void* d_out, int out_size, void* d_ws, size_t ws_size, hipStream_t stream) {
    static int grid = 0;
    if (grid == 0) {
        if (n_in != 30 || in_sizes[0] != M * DM || out_size != M * DM || ws_size < WS_END) { fprintf(stderr, "kernel_launch: unexpected shapes (n_in %d, in0 %d, out %d, ws %zu); nothing launched\n", n_in, n_in > 0 ? in_sizes[0] : -1, out_size, ws_size); grid = -1; return; }
        int dev = 0, cus = 0, per_cu = 0;
        if (hipGetDevice(&dev) != hipSuccess || hipDeviceGetAttribute(&cus, hipDeviceAttributeMultiprocessorCount, dev) != hipSuccess) { fprintf(stderr, "kernel_launch: device query failed\n"); grid = -1; return; }
        if (hipFuncSetAttribute((const void*)fwd_kernel, hipFuncAttributeMaxDynamicSharedMemorySize, LDS_BYTES) != hipSuccess) { fprintf(stderr, "kernel_launch: hipFuncSetAttribute failed\n"); grid = -1; return; }
        if (hipOccupancyMaxActiveBlocksPerMultiprocessor(&per_cu, (const void*)fwd_kernel, NWAVES * 64, LDS_BYTES) != hipSuccess || per_cu < 1) { fprintf(stderr, "kernel_launch: occupancy query reports %d\n", per_cu); }
        (void)hipGetLastError();
        grid = cus;
    }
    if (grid < 0) return;
    if (hipMemsetAsync((char*)d_ws + WS_CTL, 0, CTL_ZERO_BYTES, stream) != hipSuccess) { fprintf(stderr, "kernel_launch: memset failed\n"); return; }
    Args a{};
    for (int i = 0; i < 30; ++i) a.in[i] = (const float*)d_in[i];
    a.out = (float*)d_out; a.ws = (unsigned char*)d_ws;
    if (N_LAUNCHES == 1) {
        a.ph_lo = 0; a.ph_hi = N_PHASES;
        hipLaunchKernelGGL(fwd_kernel, dim3(grid), dim3(NWAVES * 64), LDS_BYTES, stream, a);
    } else {
        for (int li = 0; li < N_PHASES; ++li) {
#if MOE_NAIVE
            if (li == 7) continue;
#endif
            a.ph_lo = li; a.ph_hi = li + 1;
            hipLaunchKernelGGL(fwd_kernel, dim3(grid), dim3(NWAVES * 64), LDS_BYTES, stream, a);
        }
    }
    const hipError_t le = hipPeekAtLastError();
    if (le != hipSuccess) fprintf(stderr, "kernel_launch: launch failed: %s\n", hipGetErrorName(le));
}
```

```cpp
#define MK_N_LAUNCHES 1
#define RT_NAIVE 0
#define MOE_NAIVE 0
#define HY_NAIVE 0
#define NA_NAIVE 0

#include <hip/hip_runtime.h>
#include <cstdio>
#include <cstdint>
#ifndef MK_N_LAUNCHES
#define MK_N_LAUNCHES 1
#endif
#ifndef HY_NAIVE
#define HY_NAIVE 1
#endif
#ifndef NA_NAIVE
#define NA_NAIVE 1
#endif
#ifndef RT_NAIVE
#define RT_NAIVE 1
#endif
#ifndef MOE_NAIVE
#define MOE_NAIVE 1
#endif
namespace pg8 {
#define PG8_LAS __attribute__((address_space(3)))
typedef unsigned short bf16_t;
typedef short bf16x8 __attribute__((ext_vector_type(8)));
typedef float f32x4 __attribute__((ext_vector_type(4)));
typedef float f32x2 __attribute__((ext_vector_type(2)));
typedef unsigned u32x4 __attribute__((ext_vector_type(4)));
typedef unsigned u32x2 __attribute__((ext_vector_type(2)));
constexpr int BM = 256, BK = 64, HALF = 128, HTB = HALF * BK * 2  , STAGE_BYTES = 8 * HTB, NXCD = 8, WGM = 8;

__host__ __device__ __forceinline__ int lds_byte(int r, int c) { const int st = (r >> 4) * 2 + (c >> 5), rr = r & 15, cc = c & 31, ob = rr * 64 + cc * 2; return st * 1024 + (ob ^ (((ob >> 9) & 1) << 5)); }
__host__ __device__ __forceinline__ void stage_rc(int b, int& R, int& C) { const int st = b / 1024, sb = b % 1024, swz = sb ^ (((sb >> 9) & 1) << 5); R = (st >> 1) * 16 + swz / 64; C = (st & 1) * 32 + (swz % 64) / 2; }
__host__ __device__ __forceinline__ int perm32(int rho) { const int n = rho >> 4, i = rho & 15; return 8 * (i >> 2) + 4 * n + (i & 3); }

struct Unit { int pm, pn, e, aux; };

struct StaticOrder {
    int nM, nN, nwg, G, c;
    __host__ __device__ void init(int M, int N, int G_, int c_) { nM = M / BM; nN = N / BM; nwg = nM * nN; G = G_; c = c_; }
    __host__ __device__ bool next(int i, Unit& u) const {
        const long L = (long)i * G + c; if (L >= nwg) return false;
        int wgid = (int)L; { const int q = nwg / NXCD, r = nwg % NXCD, xcd = wgid % NXCD, off = wgid / NXCD; wgid = (xcd < r ? xcd * (q + 1) : r * (q + 1) + (xcd - r) * q) + off; }
        const int nig = WGM * nN, gid = wgid / nig, fm = gid * WGM, gsz = (nM - fm) < WGM ? (nM - fm) : WGM;
        u.pm = fm + ((wgid % nig) % gsz); u.pn = (wgid % nig) / gsz; u.e = 0; u.aux = 0; return true;
    }
};

__device__ __forceinline__ unsigned cvt_pk_bf16(float lo, float hi) { unsigned r; asm volatile("v_cvt_pk_bf16_f32 %0, %1, %2" : "=v"(r) : "v"(lo), "v"(hi)); return r; }

template <class Epi, class Src, bool TACC, bool GATHER, bool ALIGN_EPI, bool SP2>
__device__ __forceinline__ void gemm_phase(PG8_LAS unsigned char* lds, const int K, const Src& S, const Epi& E) {
    const int tid = threadIdx.x, wid = __builtin_amdgcn_readfirstlane(tid >> 6), lane = tid & 63, wr = wid >> 2, wc = wid & 3, fr = lane & 15, fq = lane >> 4;
    const int nt = K / BK;
    int Rr[2], Cc[2]; unsigned voffB[2];
#pragma unroll
    for (int i = 0; i < 2; ++i) { int R, C; stage_rc(tid * 16 + i * 8192, R, C); const int Rb = Epi::PERM ? ((R & ~31) + perm32(R & 31)) : R;
        Rr[i] = R; Cc[i] = C; voffB[i] = (unsigned)(Rb * K + C) * 2u; }
    const size_t kstep = (size_t)(BK * 2);
    const size_t hstep = (size_t)HALF * K * 2;
    const unsigned ldsw = (unsigned)wid * 1024u;
    const int aoff = lds_byte(wr * 64 + fr, fq * 8), boff = lds_byte(wc * 32 + fr, fq * 8);
#define PG8_SA(b, h) (((b) * 2 + (h)) * HTB)
#define PG8_SB(b, h) ((4 + (b) * 2 + (h)) * HTB)
#define PG8_STAGE(bufoff, gbase, voff) do { _Pragma("unroll") for (int _i = 0; _i < 2; ++_i) \
        __builtin_amdgcn_global_load_lds((const unsigned*)((const char*)(gbase) + (voff)[_i]), (PG8_LAS unsigned*)(lds + (bufoff) + ldsw + _i * 8192), 16, 0, 0); } while (0)
#define PG8_LDA(dst, b, h) do { _Pragma("unroll") for (int m = 0; m < 4; ++m) _Pragma("unroll") for (int k = 0; k < 2; ++k) dst[m][k] = *(const PG8_LAS bf16x8*)(lds + PG8_SA(b, h) + aoff + m * 2048 + k * 1024); } while (0)
#define PG8_LDB(dst, b, h) do { _Pragma("unroll") for (int n = 0; n < 2; ++n) _Pragma("unroll") for (int k = 0; k < 2; ++k) dst[n][k] = *(const PG8_LAS bf16x8*)(lds + PG8_SB(b, h) + boff + n * 2048 + k * 1024); } while (0)
#define PG8_MMA(ai, bj, At, Bt) do { __builtin_amdgcn_s_setprio(1); _Pragma("unroll") for (int m = 0; m < 4; ++m) _Pragma("unroll") for (int n = 0; n < 2; ++n) _Pragma("unroll") for (int k = 0; k < 2; ++k) \
        acc[ai][bj][m][n] = TACC ? __builtin_amdgcn_mfma_f32_16x16x32_bf16(Bt[n][k], At[m][k], acc[ai][bj][m][n], 0, 0, 0) \
                                 : __builtin_amdgcn_mfma_f32_16x16x32_bf16(At[m][k], Bt[n][k], acc[ai][bj][m][n], 0, 0, 0); __builtin_amdgcn_s_setprio(0); } while (0)
#define PG8_WAIT_V(n) asm volatile("s_waitcnt vmcnt(" #n ")" ::: "memory")
#define PG8_WAIT_L(n) asm volatile("s_waitcnt lgkmcnt(" #n ")" ::: "memory")
#define PG8_BAR __builtin_amdgcn_s_barrier()
#define PG8_SCHED __builtin_amdgcn_sched_barrier(0)
    Unit cur, nxt; int ui = 0;
    if (!S.next(0, cur)) return;
    f32x4 acc[2][2][4][2];
#pragma unroll
    for (int a = 0; a < 2; ++a)
#pragma unroll
        for (int b = 0; b < 2; ++b)
#pragma unroll
            for (int m = 0; m < 4; ++m)
#pragma unroll
                for (int n = 0; n < 2; ++n) acc[a][b][m][n] = (f32x4){0.f, 0.f, 0.f, 0.f};
    bf16x8 At[4][2], B0[2][2], B1[2][2];
    unsigned offA[2][2], nOffA[2][2];
    S.aoff(cur, K, Rr, Cc, offA);
    const char* cA = S.abase(cur); const char* cB = S.bbase(cur);
    if constexpr (SP2) {
        PG8_STAGE(PG8_SB(0, 0), cB, voffB); PG8_STAGE(PG8_SB(0, 1), cB + hstep, voffB); PG8_STAGE(PG8_SA(0, 0), cA, offA[0]); PG8_STAGE(PG8_SA(0, 1), cA, offA[1]);
        if (wr == 1) PG8_BAR;
        PG8_WAIT_V(2); PG8_BAR;
        PG8_STAGE(PG8_SB(1, 0), cB + kstep, voffB); PG8_STAGE(PG8_SA(1, 0), cA + kstep, offA[0]); PG8_STAGE(PG8_SB(1, 1), cB + hstep + kstep, voffB);
        PG8_WAIT_V(6); PG8_BAR;
    } else {
        PG8_STAGE(PG8_SB(0, 0), cB, voffB); PG8_STAGE(PG8_SA(0, 0), cA, offA[0]); PG8_STAGE(PG8_SB(0, 1), cB + hstep, voffB); PG8_STAGE(PG8_SA(0, 1), cA, offA[1]);
        if (wr == 1) PG8_BAR;
        PG8_WAIT_V(4); PG8_BAR;
        PG8_STAGE(PG8_SB(1, 0), cB + kstep, voffB); PG8_STAGE(PG8_SA(1, 0), cA + kstep, offA[0]); PG8_STAGE(PG8_SB(1, 1), cB + hstep + kstep, voffB);
        PG8_WAIT_V(6); PG8_BAR;
    }
    for (;;) {
        const bool has_next = S.next(ui + 1, nxt);
        const char* nA = has_next ? S.abase(nxt) : cA; const char* nB = has_next ? S.bbase(nxt) : cB;
        if constexpr (GATHER) {
            if (has_next) S.aoff(nxt, K, Rr, Cc, nOffA);
            else {
#pragma unroll
                for (int h = 0; h < 2; ++h)
#pragma unroll
                    for (int i = 0; i < 2; ++i) nOffA[h][i] = offA[h][i]; }
        }
#pragma nounroll
        for (int t = 0; t < nt; t += 2) {
            const bool last = (t == nt - 2);
            const char* a1 = cA + (size_t)(t + 1) * kstep;
            const char* a2 = last ? nA : cA + (size_t)(t + 2) * kstep; const char* b2 = last ? nB : cB + (size_t)(t + 2) * kstep;
            const char* a3 = a2 + kstep; const char* b3 = b2 + kstep;
            unsigned o2[2][2];
#pragma unroll
            for (int h = 0; h < 2; ++h)
#pragma unroll
                for (int i = 0; i < 2; ++i) o2[h][i] = (GATHER && last) ? nOffA[h][i] : offA[h][i];
            if constexpr (SP2) {
            PG8_LDB(B0, 0, 0); PG8_LDB(B1, 0, 1); PG8_SCHED; PG8_LDA(At, 0, 0); PG8_STAGE(PG8_SA(1, 1), a1, offA[1]);
            PG8_WAIT_V(8); PG8_WAIT_L(0); PG8_BAR; PG8_MMA(0, 0, At, B0); PG8_MMA(0, 1, At, B1); PG8_BAR; PG8_SCHED;
            PG8_LDA(At, 0, 1); PG8_STAGE(PG8_SB(0, 0), b2, voffB); PG8_STAGE(PG8_SB(0, 1), b2 + hstep, voffB); PG8_STAGE(PG8_SA(0, 0), a2, o2[0]);
            PG8_WAIT_V(8); PG8_WAIT_L(0); PG8_BAR; PG8_MMA(1, 0, At, B0); PG8_MMA(1, 1, At, B1); PG8_BAR; PG8_SCHED;
            PG8_LDB(B0, 1, 0); PG8_LDB(B1, 1, 1); PG8_SCHED; PG8_LDA(At, 1, 0); PG8_STAGE(PG8_SA(0, 1), a2, o2[1]);
            PG8_WAIT_V(8); PG8_WAIT_L(0); PG8_BAR; PG8_MMA(0, 0, At, B0); PG8_MMA(0, 1, At, B1); PG8_BAR; PG8_SCHED;
            PG8_LDA(At, 1, 1); PG8_STAGE(PG8_SB(1, 0), b3, voffB); PG8_STAGE(PG8_SB(1, 1), b3 + hstep, voffB); PG8_STAGE(PG8_SA(1, 0), a3, o2[0]);
            PG8_WAIT_V(8); PG8_WAIT_L(0); PG8_BAR; PG8_MMA(1, 0, At, B0); PG8_MMA(1, 1, At, B1); PG8_BAR; PG8_SCHED;
            } else {
            PG8_LDB(B0, 0, 0); PG8_SCHED; PG8_LDA(At, 0, 0); PG8_STAGE(PG8_SA(1, 1), a1, offA[1]);
            PG8_WAIT_L(8); PG8_BAR; PG8_WAIT_L(0); PG8_MMA(0, 0, At, B0); PG8_BAR; PG8_SCHED;
            PG8_LDB(B1, 0, 1); PG8_STAGE(PG8_SB(0, 0), b2, voffB);
            PG8_BAR; PG8_WAIT_L(0); PG8_MMA(0, 1, At, B1); PG8_BAR;
            PG8_LDA(At, 0, 1); PG8_STAGE(PG8_SA(0, 0), a2, o2[0]);
            PG8_BAR; PG8_WAIT_L(0); PG8_MMA(1, 0, At, B0); PG8_BAR; PG8_SCHED;
            PG8_STAGE(PG8_SB(0, 1), b2 + hstep, voffB);
            PG8_WAIT_V(6); PG8_BAR; PG8_MMA(1, 1, At, B1); PG8_BAR;
            PG8_LDB(B0, 1, 0); PG8_SCHED; PG8_LDA(At, 1, 0); PG8_STAGE(PG8_SA(0, 1), a2, o2[1]);
            PG8_WAIT_L(8); PG8_BAR; PG8_WAIT_L(0); PG8_MMA(0, 0, At, B0); PG8_BAR; PG8_SCHED;
            PG8_LDB(B1, 1, 1); PG8_STAGE(PG8_SB(1, 0), b3, voffB);
            PG8_BAR; PG8_WAIT_L(0); PG8_MMA(0, 1, At, B1); PG8_BAR;
            PG8_LDA(At, 1, 1); PG8_STAGE(PG8_SA(1, 0), a3, o2[0]);
            PG8_BAR; PG8_WAIT_L(0); PG8_MMA(1, 0, At, B0); PG8_BAR; PG8_SCHED;
            PG8_STAGE(PG8_SB(1, 1), b3 + hstep, voffB);
            PG8_WAIT_V(6); PG8_BAR; PG8_MMA(1, 1, At, B1); PG8_BAR;
            }
        }
        if constexpr (ALIGN_EPI) { if (wr == 0) PG8_BAR; }
        E(acc, cur, wr, wc, fr, fq);
        if (!has_next) break;
#pragma unroll
        for (int a = 0; a < 2; ++a)
#pragma unroll
            for (int b = 0; b < 2; ++b)
#pragma unroll
                for (int m = 0; m < 4; ++m)
#pragma unroll
                    for (int n = 0; n < 2; ++n) acc[a][b][m][n] = (f32x4){0.f, 0.f, 0.f, 0.f};
        cur = nxt; cA = nA; cB = nB; ++ui;
        if constexpr (GATHER) {
#pragma unroll
            for (int h = 0; h < 2; ++h)
#pragma unroll
                for (int i = 0; i < 2; ++i) offA[h][i] = nOffA[h][i]; }
        if constexpr (ALIGN_EPI) { if (wr == 1) PG8_BAR; }
    }
    PG8_WAIT_V(0);
    if constexpr (!ALIGN_EPI) { if (wr == 0) PG8_BAR; }
    PG8_BAR;
#undef PG8_SA
#undef PG8_SB
#undef PG8_STAGE
#undef PG8_LDA
#undef PG8_LDB
#undef PG8_MMA
#undef PG8_WAIT_V
#undef PG8_WAIT_L
#undef PG8_BAR
#undef PG8_SCHED
}
}
constexpr int NB = 16, SEQ = 2048, DM = 1024, M = NB * SEQ, PLE = 256;
constexpr int HYW = 512, NAW = 512, NH = 8, HD = 64, UTR = 2048;
constexpr int NE = 32, DE = 512, LCAP = M;
constexpr int GSTR = 4104;
constexpr float EPS = 1e-6f;
constexpr int NWAVES = 8;

constexpr size_t MiB = 1u << 20, KiB = 1u << 10;
constexpr size_t WS_CTL = 0, CTL_ZERO_BYTES = 1 * MiB;
constexpr size_t WS_RSX = 1 * MiB, WS_RS1 = WS_RSX + 128 * KiB, WS_RS2 = WS_RS1 + 128 * KiB;
constexpr size_t WS_WR = 1 * MiB + 512 * KiB;
constexpr size_t WS_GATE = 2 * MiB;
constexpr size_t WS_LIST = 4 * MiB;
constexpr size_t WS_WIN = 8 * MiB, WS_WOUT = 14 * MiB, WS_WG = 16 * MiB, WS_WP = 18 * MiB;
constexpr size_t WS_HYK = 20 * MiB;
constexpr size_t WS_W13 = 30 * MiB, WS_W2 = 94 * MiB;
constexpr size_t WS_PB = 126 * MiB;
constexpr size_t WS_A1 = 142 * MiB;
constexpr size_t WS_A2 = 206 * MiB;
constexpr size_t WS_A3 = 334 * MiB;
constexpr size_t WS_A4 = 414 * MiB;
constexpr size_t WS_END = 478 * MiB;
constexpr size_t WS_XB = WS_A1, WS_YK0 = WS_A1, WS_H3 = WS_A1;
constexpr size_t WS_MIX = WS_A2 + 64 * MiB;
constexpr size_t WS_UT = WS_A2, WS_H1 = WS_A2, WS_H2 = WS_A2 + 64 * MiB;
constexpr size_t WS_Q = WS_A3, WS_K = WS_A3 + 32 * MiB, WS_HID = WS_A3, WS_PL = WS_A3;
constexpr size_t WS_YT = WS_A4, WS_YNA = WS_A4 + 32 * MiB, WS_YK1 = WS_A4;
static_assert(WS_HYK + (size_t)1024 * GSTR * 2 <= WS_W13 && WS_A3 + (size_t)(2 * M + NE * 256) * DE * 2 <= WS_A4, "d_ws map");
constexpr int CW_TMO = 0, CW_CODE = 1;
constexpr int CW_BAR = 4096;
constexpr int CW_CNT = 8192;
constexpr int RING_OFF = 0, RING_BYTES = 131072;
constexpr int LDS_BYTES = 163840;
constexpr int LDSCTL_OFF = LDS_BYTES - 512, TAB_OFF = LDSCTL_OFF, MISC_OFF = LDSCTL_OFF + 320;
constexpr int SCRATCH_BYTES = LDSCTL_OFF;

#define GAS __attribute__((address_space(1)))
#define LAS __attribute__((address_space(3)))
typedef unsigned short bf16;
typedef unsigned v4u __attribute__((ext_vector_type(4)));
typedef unsigned v2u __attribute__((ext_vector_type(2)));
typedef float f32x4 __attribute__((ext_vector_type(4)));
typedef short bf16x8 __attribute__((ext_vector_type(8)));
typedef GAS unsigned gu32;
#define RLX_AGENT __ATOMIC_RELAXED, __HIP_MEMORY_SCOPE_AGENT
#define LDS_WAIT() asm volatile("s_waitcnt lgkmcnt(0)" ::: "memory")
#define VM_WAIT() asm volatile("s_waitcnt vmcnt(0)" ::: "memory")
__device__ __forceinline__ unsigned f2bf(float f) { unsigned u = __builtin_bit_cast(unsigned, f); return (u + 0x7fffu + ((u >> 16) & 1u)) >> 16; }
__device__ __forceinline__ unsigned pk2(float lo, float hi) { return f2bf(lo) | (f2bf(hi) << 16); }
__device__ __forceinline__ float bf2f(unsigned b) { return __builtin_bit_cast(float, b << 16); }
__device__ __forceinline__ float bflo(unsigned w) { return __builtin_bit_cast(float, w << 16); }
__device__ __forceinline__ float bfhi(unsigned w) { return __builtin_bit_cast(float, w & 0xffff0000u); }
__device__ __forceinline__ float bfr(float f) { return bf2f(f2bf(f)); }
__device__ __forceinline__ float wave_sum(float v) {
#pragma unroll
    for (int o = 1; o < 64; o <<= 1) v += __shfl_xor(v, o);
    return v;
}

#define XB_TMO      128
#define XB_XCNT(j)  (256  + 64 * (j))
#define XB_XSUB(j)  (1280 + 64 * (j))
#define XB_XGEN(j)  (2304 + 64 * (j))
#define XB_TOP      3328
#define XB_TOPGEN   3392
#define XCD_BAR_WORDS 3456
#define XB_SPIN_CAP (1u << 18)

__device__ __forceinline__ unsigned xb_ld(unsigned* p)              { return __hip_atomic_load(p, __ATOMIC_RELAXED, __HIP_MEMORY_SCOPE_AGENT); }
__device__ __forceinline__ unsigned xb_add(unsigned* p, unsigned v) { return __hip_atomic_fetch_add(p, v, __ATOMIC_RELAXED, __HIP_MEMORY_SCOPE_AGENT); }
__device__ __forceinline__ unsigned xb_xcc_id() { return (unsigned)__builtin_amdgcn_s_getreg((3 << 11) | 20) & 0xFu; }
#define XB_SPIN(cond, bar) do { unsigned _sp = 0; while (cond) { __builtin_amdgcn_s_sleep(1); \
    if ((++_sp & 255u) == 0u) { if (xb_ld(&(bar)[XB_TMO])) break; if (_sp > XB_SPIN_CAP) { atomicAdd(&(bar)[XB_TMO], 1u); break; } } } } while (0)

struct XcdBarrier {
    unsigned* bar; unsigned x;
    volatile LAS unsigned* st;
};

__device__ __forceinline__ XcdBarrier xcd_barrier_post(unsigned* bar, volatile LAS unsigned* st) {
    XcdBarrier b; b.bar = bar; b.x = xb_xcc_id(); b.st = st;
    if (threadIdx.x == 0) (void)xb_add(&bar[XB_XCNT(b.x)], 1u);
    return b;
}
__device__ __forceinline__ void xcd_barrier_complete(unsigned* bar, unsigned x, unsigned& nloc, unsigned& nx) {
    const unsigned G = gridDim.x * gridDim.y * gridDim.z;
    unsigned sum, cnt, mine, sp = 0u;
    for (;;) {
        sum = 0u; cnt = 0u; mine = 0u;
#pragma unroll
        for (unsigned j = 0; j < 16; ++j) { const unsigned c = xb_ld(&bar[XB_XCNT(j)]); sum += c; cnt += (c > 0u) ? 1u : 0u; mine = (j == x) ? c : mine; }
        if (sum == G) break;
        __builtin_amdgcn_s_sleep(1);
        if ((++sp & 255u) == 0u) { if (xb_ld(&bar[XB_TMO])) break; if (sp > XB_SPIN_CAP) { atomicAdd(&bar[XB_TMO], 1u); break; } }
    }
    nloc = mine > 0u ? mine : 1u; nx = cnt > 0u ? cnt : 1u;
}

__device__ __forceinline__ void xcd_barrier(const XcdBarrier& b) {
    asm volatile("s_waitcnt vmcnt(0)" ::: "memory");
    __syncthreads();
    if (threadIdx.x == 0) {
        unsigned* bar = b.bar;
        __builtin_amdgcn_s_waitcnt(0);
        unsigned nloc = b.st[0], nx = b.st[1];
        if (nloc == 0u) { xcd_barrier_complete(bar, b.x, nloc, nx); b.st[0] = nloc; b.st[1] = nx; }
        const unsigned old = xb_add(&bar[XB_XSUB(b.x)], 1u);
        const unsigned gen = old / nloc;
        if (old + 1u == (gen + 1u) * nloc) {
            __builtin_amdgcn_fence(__ATOMIC_RELEASE, "agent");
            asm volatile("s_waitcnt vmcnt(0)" ::: "memory");
            const unsigned og = xb_add(&bar[XB_TOP], 1u);
            const unsigned tg = og / nx;
            if (og + 1u == (tg + 1u) * nx) xb_add(&bar[XB_TOPGEN], 1u);
            else XB_SPIN(xb_ld(&bar[XB_TOPGEN]) == tg, bar);
            __builtin_amdgcn_fence(__ATOMIC_ACQUIRE, "agent");
            xb_add(&bar[XB_XGEN(b.x)], 1u);
            asm volatile("s_waitcnt vmcnt(0)" ::: "memory");
        } else {
            XB_SPIN(xb_ld(&bar[XB_XGEN(b.x)]) == gen, bar);
            __builtin_amdgcn_fence(__ATOMIC_ACQUIRE, "agent");
            asm volatile("s_waitcnt vmcnt(0)" ::: "memory");
        }
    }
    __syncthreads();
}
struct Frame {
    LAS unsigned char* lds;
    volatile LAS unsigned* MISC;
    gu32* ctl;
    int tid, lane, wave;
    int vcu, G;
    const float* const* in; float* out; unsigned char* ws;
};
#define WSP(T, off) ((T*)(F.ws + (off)))

struct DenseSrc : pg8::StaticOrder {
    const char* A; const char* B; size_t tstepA, tstepB;
    __device__ __forceinline__ void set(const void* A_, const void* B_, int M_, int N_, int K_, int G_, int c_) { init(M_, N_, G_, c_); A = (const char*)A_; B = (const char*)B_; tstepA = (size_t)256 * K_ * 2; tstepB = (size_t)256 * K_ * 2; }
    __device__ __forceinline__ const char* abase(const pg8::Unit& u) const { return A + (size_t)u.pm * tstepA; }
    __device__ __forceinline__ const char* bbase(const pg8::Unit& u) const { return B + (size_t)u.pn * tstepB; }
    __device__ __forceinline__ void aoff(const pg8::Unit&, int K, const int (&R)[2], const int (&C)[2], unsigned (&off)[2][2]) const {
#pragma unroll
        for (int h = 0; h < 2; ++h)
#pragma unroll
            for (int i = 0; i < 2; ++i) off[h][i] = (unsigned)((128 * h + R[i]) * K + C[i]) * 2u;
    }
};

using pg8::f32x4; using pg8::Unit;
struct EpiUT {
    static constexpr bool PERM = false;
    bf16* UT; const float* rstd;
    __device__ __forceinline__ void operator()(const f32x4 (&acc)[2][2][4][2], const Unit& u, int wr, int wc, int fr, int fq) const {
#pragma unroll
        for (int ai = 0; ai < 2; ++ai)
#pragma unroll
            for (int m = 0; m < 4; ++m) {
                const int tok0 = u.pm * 256 + ai * 128 + wr * 64 + m * 16 + 4 * fq;
                const f32x4 rs = *(const f32x4*)(rstd + tok0);
#pragma unroll
                for (int bj = 0; bj < 2; ++bj)
#pragma unroll
                    for (int n = 0; n < 2; ++n) {
                        const int col = u.pn * 256 + bj * 128 + wc * 32 + n * 16 + fr;
                        const f32x4 v = acc[ai][bj][m][n] * rs;
                        v2u w; w.x = pg8::cvt_pk_bf16(v[0], v[1]); w.y = pg8::cvt_pk_bf16(v[2], v[3]);
                        *(v2u*)(UT + (size_t)col * M + tok0) = w; }
            }
    }
};
#if NA_NAIVE
constexpr float QSCALE = 0.125f;
#else
constexpr float QSCALE = 0.125f * 1.4426950408889634f;
#endif
struct EpiQK {
    static constexpr bool PERM = true;
    bf16* Q; bf16* Kp; const float* rstd;
    __device__ __forceinline__ void operator()(const f32x4 (&acc)[2][2][4][2], const Unit& u, int wr, int wc, int fr, int fq) const {
        const int row0 = u.pm * 256 + wr * 64 + fr; const int t = u.pn >> 1; bf16* base = t ? Kp : Q; const float sc = t ? 1.f : QSCALE;
        const int col0 = (u.pn & 1) * 256 + wc * 32 + 8 * fq;
#pragma unroll
        for (int ai = 0; ai < 2; ++ai)
#pragma unroll
            for (int m = 0; m < 4; ++m) { const int row = row0 + ai * 128 + m * 16; const float r = rstd[row] * sc; bf16* rowp = base + (size_t)row * 512 + col0;
#pragma unroll
                for (int bj = 0; bj < 2; ++bj) { const f32x4 v0 = acc[ai][bj][m][0] * r, v1 = acc[ai][bj][m][1] * r;
                    v4u w; w.x = pg8::cvt_pk_bf16(v0[0], v0[1]); w.y = pg8::cvt_pk_bf16(v0[2], v0[3]); w.z = pg8::cvt_pk_bf16(v1[0], v1[1]); w.w = pg8::cvt_pk_bf16(v1[2], v1[3]);
                    *(v4u*)(rowp + bj * 128) = w; } }
    }
};
struct EpiH1 {
    static constexpr bool PERM = true;
    bf16* H1; const bf16* xb;
    __device__ __forceinline__ void operator()(const f32x4 (&acc)[2][2][4][2], const Unit& u, int wr, int wc, int fr, int fq) const {
        const int row0 = u.pm * 256 + wr * 64 + fr; const int col0 = u.pn * 256 + wc * 32 + 8 * fq;
#pragma unroll
        for (int ai = 0; ai < 2; ++ai)
#pragma unroll
            for (int m = 0; m < 4; ++m) { const size_t ro = (size_t)(row0 + ai * 128 + m * 16) * DM + col0;
#pragma unroll
                for (int bj = 0; bj < 2; ++bj) { const v4u xw = *(const v4u*)(xb + ro + bj * 128);
                    const f32x4 v0 = acc[ai][bj][m][0], v1 = acc[ai][bj][m][1];
                    v4u w; w.x = pg8::cvt_pk_bf16(v0[0] + bflo(xw.x), v0[1] + bfhi(xw.x)); w.y = pg8::cvt_pk_bf16(v0[2] + bflo(xw.y), v0[3] + bfhi(xw.y));
                    w.z = pg8::cvt_pk_bf16(v1[0] + bflo(xw.z), v1[1] + bfhi(xw.z)); w.w = pg8::cvt_pk_bf16(v1[2] + bflo(xw.w), v1[3] + bfhi(xw.w));
                    *(v4u*)(H1 + ro + bj * 128) = w; } }
    }
};
struct EpiPL {
    static constexpr bool PERM = true;
    bf16* PL;
    __device__ __forceinline__ void operator()(const f32x4 (&acc)[2][2][4][2], const Unit& u, int wr, int wc, int fr, int fq) const {
        const int row0 = u.pm * 256 + wr * 64 + fr; const int col0 = u.pn * 256 + wc * 32 + 8 * fq;
#pragma unroll
        for (int ai = 0; ai < 2; ++ai)
#pragma unroll
            for (int m = 0; m < 4; ++m) { const size_t ro = (size_t)(row0 + ai * 128 + m * 16) * DM + col0;
#pragma unroll
                for (int bj = 0; bj < 2; ++bj) { const f32x4 v0 = acc[ai][bj][m][0], v1 = acc[ai][bj][m][1];
                    v4u w; w.x = pg8::cvt_pk_bf16(v0[0], v0[1]); w.y = pg8::cvt_pk_bf16(v0[2], v0[3]); w.z = pg8::cvt_pk_bf16(v1[0], v1[1]); w.w = pg8::cvt_pk_bf16(v1[2], v1[3]);
                    *(v4u*)(PL + ro + bj * 128) = w; } }
    }
};
__device__ __forceinline__ float sigmoidf_(float v) { return 1.f / (1.f + __expf(-v)); }
struct EpiPLE {
    static constexpr bool PERM = true;
    bf16* H3; const bf16* H2; const bf16* PL; const float* rstd;
    __device__ __forceinline__ void operator()(const f32x4 (&acc)[2][2][4][2], const Unit& u, int wr, int wc, int fr, int fq) const {
        const int row0 = u.pm * 256 + wr * 64 + fr; const int col0 = u.pn * 256 + wc * 32 + 8 * fq;
#pragma unroll
        for (int ai = 0; ai < 2; ++ai)
#pragma unroll
            for (int m = 0; m < 4; ++m) { const int row = row0 + ai * 128 + m * 16; const size_t ro = (size_t)row * DM + col0; const float r = rstd[row];
#pragma unroll
                for (int bj = 0; bj < 2; ++bj) { const v4u h = *(const v4u*)(H2 + ro + bj * 128), p = *(const v4u*)(PL + ro + bj * 128);
                    const f32x4 a0 = acc[ai][bj][m][0] * r, a1 = acc[ai][bj][m][1] * r;
                    float o[8];
                    o[0] = bflo(h.x) + bflo(p.x) * sigmoidf_(a0[0]); o[1] = bfhi(h.x) + bfhi(p.x) * sigmoidf_(a0[1]);
                    o[2] = bflo(h.y) + bflo(p.y) * sigmoidf_(a0[2]); o[3] = bfhi(h.y) + bfhi(p.y) * sigmoidf_(a0[3]);
                    o[4] = bflo(h.z) + bflo(p.z) * sigmoidf_(a1[0]); o[5] = bfhi(h.z) + bfhi(p.z) * sigmoidf_(a1[1]);
                    o[6] = bflo(h.w) + bflo(p.w) * sigmoidf_(a1[2]); o[7] = bfhi(h.w) + bfhi(p.w) * sigmoidf_(a1[3]);
                    v4u w; w.x = pg8::cvt_pk_bf16(o[0], o[1]); w.y = pg8::cvt_pk_bf16(o[2], o[3]); w.z = pg8::cvt_pk_bf16(o[4], o[5]); w.w = pg8::cvt_pk_bf16(o[6], o[7]);
                    *(v4u*)(H3 + ro + bj * 128) = w; } }
    }
};

constexpr int P0_SCR = 64 * 68 * 4;
static_assert(8 * P0_SCR <= SCRATCH_BYTES, "P0 LDS");
template <class GainF, class RowF>
__device__ __forceinline__ void p0_transpose_item(const float* W, int N, bf16* WT, int ldk, LAS float* scr, int item, int lane, GainF gain, RowF rowmap) {
    const int nblk = N / 64, kb = item / nblk, nb = item % nblk, k0 = 64 * kb, n0 = 64 * nb;
    const int lr = lane >> 4, lc = (lane & 15) * 4;
    f32x4 v[16];
#pragma unroll
    for (int i = 0; i < 16; ++i) v[i] = *(const GAS f32x4*)(W + (size_t)(k0 + 4 * i + lr) * N + n0 + lc);
#pragma unroll
    for (int i = 0; i < 16; ++i) { const float g = gain(k0 + 4 * i + lr); *(LAS f32x4*)(scr + (4 * i + lr) * 68 + lc) = v[i] * g; }
    LDS_WAIT(); asm volatile("" ::: "memory");
    const int c = lane & 7;
#pragma unroll
    for (int j = 0; j < 8; ++j) { const int n = (lane >> 3) + 8 * j; const LAS float* s = scr + (8 * c) * 68 + n;
        v4u o; o.x = pk2(s[0 * 68], s[1 * 68]); o.y = pk2(s[2 * 68], s[3 * 68]); o.z = pk2(s[4 * 68], s[5 * 68]); o.w = pk2(s[6 * 68], s[7 * 68]);
        *(GAS v4u*)(WT + (size_t)rowmap(n0 + n) * ldk + k0 + 8 * c) = o; }
    LDS_WAIT(); asm volatile("" ::: "memory");
}
typedef float f32x16_ __attribute__((ext_vector_type(16)));
constexpr size_t WS_HID2F = 3 * MiB;
__device__ __forceinline__ void p0_filter_hidden(Frame& F) {
    const int lane = F.lane, gw = F.vcu * NWAVES + F.wave, NGW = F.G * NWAVES;
    const float* w1 = F.in[6]; const float* b1 = F.in[7]; const float* f1 = F.in[8]; const float* w2 = F.in[9]; const float* b2 = F.in[10]; const float* f2 = F.in[11];
    float* H2 = WSP(float, WS_HID2F);
    const float band = 1e-4f + (float)((lane - 1) & 15) * ((15.0f - 1e-4f) / 15.0f);
    for (int n = gw; n < SEQ; n += NGW) {
        const float t = (float)n * (1.0f / 2047.0f); const float w = 6.283185307179586f * (float)n * (1.0f / 2048.0f);
        float z = 0.f;
        if (lane == 0) z = t;
        else if (lane <= 16) z = __cosf(band * w);
        else if (lane <= 32) z = -__sinf(band * w);
        float a = b1[lane];
#pragma unroll
        for (int i = 0; i < 33; ++i) a += __shfl(z, i) * w1[i * 64 + lane];
        const float h1 = __sinf(f1[lane] * a);
        float a2 = b2[lane];
#pragma unroll 16
        for (int j = 0; j < 64; ++j) a2 += __shfl(h1, j) * w2[j * 64 + lane];
        H2[n * 64 + lane] = __sinf(f2[lane] * a2);
    }
}
__device__ __forceinline__ void p1_filter_expand(Frame& F) {
    const int lane = F.lane, gw = F.vcu * NWAVES + F.wave, NGW = F.G * NWAVES, li = lane & 31, lk = lane >> 5;
    const float* w3 = F.in[12]; const float* H2 = WSP(float, WS_HID2F); bf16* HYK = WSP(bf16, WS_HYK);
    for (int tt = gw; tt < 64 * 64; tt += NGW) {
        const int pb = tt >> 6, col = (tt & 63) * 32 + li;
        f32x16_ acc = {0.f, 0.f, 0.f, 0.f, 0.f, 0.f, 0.f, 0.f, 0.f, 0.f, 0.f, 0.f, 0.f, 0.f, 0.f, 0.f};
        const float* ap = H2 + (size_t)(pb * 32 + li) * 64 + lk; const float* bp = w3 + (size_t)lk * 2048 + col;
#pragma unroll 16
        for (int kk = 0; kk < 32; ++kk) acc = __builtin_amdgcn_mfma_f32_32x32x2f32(ap[2 * kk], bp[(size_t)kk * 4096], acc, 0, 0, 0);
        const int dir = col >> 10, o = (col >> 9) & 1, c = col & 511;
        const float dl = 3.0701134573253944f + (float)c * ((15.350567286626972f - 3.0701134573253944f) / 511.0f);
        bf16* grow = HYK + (size_t)(o * 512 + c) * GSTR + 2048;
#pragma unroll
        for (int rg = 0; rg < 16; ++rg) { const int n = pb * 32 + (rg & 3) + 8 * (rg >> 2) + 4 * lk; const float t = (float)n * (1.0f / 2047.0f);
            const float val = acc[rg] * __expf(-t * dl);
            if (!(dir == 1 && n == 0)) grow[dir ? n : -n] = (bf16)f2bf(val); }
    }
}
#ifndef P0_REP_F
#define P0_REP_F 1
#endif
#ifndef P0_REP_T
#define P0_REP_T 1
#endif
#ifndef P0_REP_X
#define P0_REP_X 1
#endif
__device__ __forceinline__ void p0_prologue(Frame& F) {
    LAS float* scr = (LAS float*)(F.lds + F.wave * P0_SCR);
    const int gw = F.vcu * NWAVES + F.wave, NGW = F.G * NWAVES, lane = F.lane;
    p0_filter_hidden(F);
    { bf16* HYK = WSP(bf16, WS_HYK);
      for (int i = blockIdx.x * 512 + F.tid; i < 1024 * 9; i += F.G * 512) { const int row = i / 9, j = i % 9; HYK[(size_t)row * GSTR + (j == 0 ? 0 : 4095 + j)] = 0; } }
    {
        const float* g_mix = F.in[2]; const float* g_ohy = F.in[15]; const float* g_ona = F.in[16]; const float* g_ffn = F.in[18]; const float* g_ple = F.in[26];
        constexpr int I_IN = 16 * 48, I_OUT = 16 * 16, I_G = 16 * 16, I_P = 4 * 16, I_E1 = 16 * 8, I_E2 = 8 * 16;
        constexpr int NITEMS = I_IN + I_OUT + I_G + I_P + NE * (2 * I_E1 + I_E2);
        for (int it_ = gw; it_ < NITEMS * P0_REP_T; it_ += NGW) {
            const int it = it_ % NITEMS; int r = it;
            if (r < I_IN) { p0_transpose_item(F.in[3], 3072, WSP(bf16, WS_WIN), DM, scr, r, lane, [&](int k) { return g_mix[k]; },
                                              [](int n) { return n < 1536 ? n : (n < 2560 ? n + 512 : n - 1024); }); continue; } r -= I_IN;
            if (r < I_OUT) { p0_transpose_item(F.in[17], 1024, WSP(bf16, WS_WOUT), DM, scr, r, lane, [&](int k) { return k < 512 ? g_ohy[k] : g_ona[k - 512]; }, [](int n) { return n; }); continue; } r -= I_OUT;
            if (r < I_G) { p0_transpose_item(F.in[27], 1024, WSP(bf16, WS_WG), DM, scr, r, lane, [&](int k) { return g_ple[k]; }, [](int n) { return n; }); continue; } r -= I_G;
            if (r < I_P) { p0_transpose_item(F.in[28], 1024, WSP(bf16, WS_WP), PLE, scr, r, lane, [](int) { return 1.0f; }, [](int n) { return n; }); continue; } r -= I_P;
            const int e = r / (2 * I_E1 + I_E2); r -= e * (2 * I_E1 + I_E2);
            if (r < I_E1) { p0_transpose_item(F.in[23] + (size_t)e * DM * DE, DE, WSP(bf16, WS_W13) + (size_t)e * 1024 * DM, DM, scr, r, lane, [&](int k) { return g_ffn[k]; }, [](int n) { return (n >> 2) * 8 + (n & 3); }); continue; } r -= I_E1;
            if (r < I_E1) { p0_transpose_item(F.in[24] + (size_t)e * DM * DE, DE, WSP(bf16, WS_W13) + (size_t)e * 1024 * DM, DM, scr, r, lane, [&](int k) { return g_ffn[k]; }, [](int n) { return (n >> 2) * 8 + (n & 3) + 4; }); continue; } r -= I_E1;
            p0_transpose_item(F.in[25] + (size_t)e * DE * DM, DM, WSP(bf16, WS_W2) + (size_t)e * DM * DE, DE, scr, r, lane, [](int) { return 1.0f; }, [](int n) { return n; });
        }
#if RT_NAIVE
        float* WR = WSP(float, WS_WR);
        for (int i = blockIdx.x * 512 + F.tid; i < 36 * 1024; i += F.G * 512) { const int j = i >> 10, k = i & 1023;
            WR[i] = (j < 4 ? F.in[19][k * 4 + j] : F.in[21][k * 32 + (j - 4)]) * g_ffn[k]; }
#endif
    }
    {
        const float* x = F.in[0]; bf16* XB = WSP(bf16, WS_XB); float* rsx = WSP(float, WS_RSX);
        for (int m_ = gw * 2; m_ < M * P0_REP_X; m_ += NGW * 2) { const int m = m_ % M;
            f32x4 v[2][4]; float s[2] = {0.f, 0.f};
#pragma unroll
            for (int q = 0; q < 2; ++q)
#pragma unroll
                for (int j = 0; j < 4; ++j) v[q][j] = ((const GAS f32x4*)(x + (size_t)(m + q) * DM))[lane + 64 * j];
#pragma unroll
            for (int q = 0; q < 2; ++q)
#pragma unroll
                for (int j = 0; j < 4; ++j) s[q] += (v[q][j].x * v[q][j].x + v[q][j].y * v[q][j].y) + (v[q][j].z * v[q][j].z + v[q][j].w * v[q][j].w);
#pragma unroll
            for (int o = 1; o < 64; o <<= 1) { s[0] += __shfl_xor(s[0], o); s[1] += __shfl_xor(s[1], o); }
            if (lane < 2) rsx[m + lane] = rsqrtf((lane ? s[1] : s[0]) * (1.0f / DM) + EPS);
#pragma unroll
            for (int q = 0; q < 2; ++q)
#pragma unroll
                for (int j = 0; j < 4; ++j) { v2u w; w.x = pk2(v[q][j].x, v[q][j].y); w.y = pk2(v[q][j].z, v[q][j].w); ((GAS v2u*)(XB + (size_t)(m + q) * DM))[lane + 64 * j] = w; }
        }
        const float* p = F.in[1]; bf16* PB = WSP(bf16, WS_PB);
        for (int m = gw * 4; m < M; m += NGW * 4) {
            f32x4 v[4];
#pragma unroll
            for (int q = 0; q < 4; ++q) v[q] = ((const GAS f32x4*)(p + (size_t)(m + q) * PLE))[lane];
#pragma unroll
            for (int q = 0; q < 4; ++q) { v2u w; w.x = pk2(v[q].x, v[q].y); w.y = pk2(v[q].z, v[q].w); ((GAS v2u*)(PB + (size_t)(m + q) * PLE))[lane] = w; }
        }
    }
}

__device__ __forceinline__ float sc3(const bf16* u, int s, float w0, float w1, float w2, float cb) {
    const float um = s > 0 ? bf2f(u[s - 1]) : 0.f, u0 = bf2f(u[s]), up = s < SEQ - 1 ? bf2f(u[s + 1]) : 0.f;
    return cb + w0 * um + w1 * u0 + w2 * up;
}
__device__ __forceinline__ void hyena_naive(Frame& F) {
    LAS float* Gl = (LAS float*)F.lds; LAS float* z = Gl + 4112;
    const bf16* UT = WSP(bf16, WS_UT); const bf16* HYK = WSP(bf16, WS_HYK); bf16* YT = WSP(bf16, WS_YT);
    const float* cw = F.in[4]; const float* cbv = F.in[5]; const float* skip = F.in[13];
    const int tid = F.tid;
    for (int unit = blockIdx.x; unit < HYW * NB; unit += F.G) {
        const int c = unit / NB, b = unit % NB;
        const bf16* ux1 = UT + (size_t)c * M + b * SEQ; const bf16* ux2 = UT + (size_t)(512 + c) * M + b * SEQ; const bf16* uv = UT + (size_t)(1024 + c) * M + b * SEQ;
        __syncthreads();
        for (int s = tid; s < SEQ; s += 512) z[s] = bfr(sc3(uv, s, cw[1024 + c], cw[1536 + 1024 + c], cw[3072 + 1024 + c], cbv[1024 + c]));
        for (int o = 0; o < 2; ++o) {
            for (int q = tid; q < GSTR; q += 512) Gl[q] = bf2f(HYK[(size_t)(o * 512 + c) * GSTR + q]);
            __syncthreads();
            const int t4 = tid * 4; float acc[4] = {0.f, 0.f, 0.f, 0.f};
            for (int s = 0; s < SEQ; ++s) { const float zs = z[s];
#pragma unroll
                for (int j = 0; j < 4; ++j) acc[j] += Gl[2048 - (t4 + j) + s] * zs; }
            const bf16* ug = o ? ux2 : ux1; const int gc = o ? 512 + c : c; const float sk = skip[o * 512 + c];
            float outv[4];
#pragma unroll
            for (int j = 0; j < 4; ++j) { const float g = sc3(ug, t4 + j, cw[gc], cw[1536 + gc], cw[3072 + gc], cbv[gc]); outv[j] = g * (acc[j] + z[t4 + j] * sk); }
            __syncthreads();
            if (o == 0) {
#pragma unroll
                for (int j = 0; j < 4; ++j) z[t4 + j] = bfr(outv[j]);
            } else {
                v2u w; w.x = pk2(outv[0], outv[1]); w.y = pk2(outv[2], outv[3]); *(v2u*)(YT + (size_t)c * M + b * SEQ + t4) = w;
            }
            __syncthreads();
        }
    }
}
__device__ __forceinline__ void natten_naive(Frame& F) {
    const bf16* Q = WSP(bf16, WS_Q); const bf16* Kb = WSP(bf16, WS_K); const bf16* VT = WSP(bf16, WS_UT) + (size_t)1536 * M; bf16* YNA = WSP(bf16, WS_YNA);
    const float* rpb = F.in[14];
    for (int unit = blockIdx.x; unit < M / 64; unit += F.G) {
        const int b = unit >> 5, r = unit & 31, h = F.tid >> 6, qc = F.tid & 63;
        const int tok = b * SEQ + r * 64 + qc;
        float q[64], o[64];
#pragma unroll
        for (int d8 = 0; d8 < 8; ++d8) { const v4u w = *(const v4u*)(Q + (size_t)tok * 512 + h * 64 + d8 * 8);
            q[d8 * 8 + 0] = bflo(w.x); q[d8 * 8 + 1] = bfhi(w.x); q[d8 * 8 + 2] = bflo(w.y); q[d8 * 8 + 3] = bfhi(w.y); q[d8 * 8 + 4] = bflo(w.z); q[d8 * 8 + 5] = bfhi(w.z); q[d8 * 8 + 6] = bflo(w.w); q[d8 * 8 + 7] = bfhi(w.w); }
#pragma unroll
        for (int d = 0; d < 64; ++d) o[d] = 0.f;
        const int rs0 = min(max(r - 4, 0), 24), cs0 = min(max(qc - 8, 0), 48);
        float mx = -1e30f, l = 0.f;
        for (int kk = 0; kk < 128; ++kk) {
            const int krow = rs0 + (kk >> 4), kcol = cs0 + (kk & 15), kt = b * SEQ + krow * 64 + kcol;
            float s = 0.f;
#pragma unroll
            for (int d8 = 0; d8 < 8; ++d8) { const v4u w = *(const v4u*)(Kb + (size_t)kt * 512 + h * 64 + d8 * 8);
                s += q[d8 * 8 + 0] * bflo(w.x) + q[d8 * 8 + 1] * bfhi(w.x) + q[d8 * 8 + 2] * bflo(w.y) + q[d8 * 8 + 3] * bfhi(w.y) + q[d8 * 8 + 4] * bflo(w.z) + q[d8 * 8 + 5] * bfhi(w.z) + q[d8 * 8 + 6] * bflo(w.w) + q[d8 * 8 + 7] * bfhi(w.w); }
            s += rpb[(h * 15 + (krow - r + 7)) * 31 + (kcol - qc + 15)];
            const float mn = fmaxf(mx, s), scl = __expf(mx - mn), p = __expf(s - mn);
            l = l * scl + p; mx = mn;
#pragma unroll
            for (int d = 0; d < 64; ++d) o[d] = o[d] * scl + p * bf2f(VT[(size_t)(h * 64 + d) * M + kt]);
        }
        const float inv = 1.f / l;
#pragma unroll
        for (int d8 = 0; d8 < 8; ++d8) { v4u w; w.x = pk2(o[d8 * 8] * inv, o[d8 * 8 + 1] * inv); w.y = pk2(o[d8 * 8 + 2] * inv, o[d8 * 8 + 3] * inv); w.z = pk2(o[d8 * 8 + 4] * inv, o[d8 * 8 + 5] * inv); w.w = pk2(o[d8 * 8 + 6] * inv, o[d8 * 8 + 7] * inv);
            *(v4u*)(YNA + (size_t)tok * 512 + h * 64 + d8 * 8) = w; }
    }
}

__device__ __forceinline__ void mixnorm(Frame& F) {
    LAS bf16* T = (LAS bf16*)F.lds; constexpr int TP = 520;
    const bf16* YT = WSP(bf16, WS_YT); const bf16* YNA = WSP(bf16, WS_YNA); bf16* MIX = WSP(bf16, WS_MIX);
    const int tid = F.tid, lane = F.lane, wave = F.wave;
    for (int unit = blockIdx.x; unit < M / 64; unit += F.G) {
        const int tok0 = unit * 64;
        __syncthreads();
#pragma unroll
        for (int it = 0; it < 8; ++it) { const int idx = it * 512 + tid, c = idx >> 3, tg = idx & 7;
            const v4u w = *(const v4u*)(YT + (size_t)c * M + tok0 + tg * 8);
            LAS bf16* d = T + (tg * 8) * TP + c;
            d[0 * TP] = (bf16)(w.x & 0xffff); d[1 * TP] = (bf16)(w.x >> 16); d[2 * TP] = (bf16)(w.y & 0xffff); d[3 * TP] = (bf16)(w.y >> 16);
            d[4 * TP] = (bf16)(w.z & 0xffff); d[5 * TP] = (bf16)(w.z >> 16); d[6 * TP] = (bf16)(w.w & 0xffff); d[7 * TP] = (bf16)(w.w >> 16); }
        __syncthreads();
#pragma unroll
        for (int i = 0; i < 8; ++i) { const int tl = wave * 8 + i, tok = tok0 + tl;
            {   const v4u w = *(const LAS v4u*)(T + tl * TP + lane * 8);
                float v[8] = {bflo(w.x), bfhi(w.x), bflo(w.y), bfhi(w.y), bflo(w.z), bfhi(w.z), bflo(w.w), bfhi(w.w)}; float s = 0.f;
#pragma unroll
                for (int j = 0; j < 8; ++j) s += v[j] * v[j];
                const float r = rsqrtf(wave_sum(s) * (1.0f / HYW) + EPS);
                v4u o; o.x = pk2(v[0] * r, v[1] * r); o.y = pk2(v[2] * r, v[3] * r); o.z = pk2(v[4] * r, v[5] * r); o.w = pk2(v[6] * r, v[7] * r);
                *(v4u*)(MIX + (size_t)tok * DM + lane * 8) = o; }
#if 1
            {   const v4u w = *(const v4u*)(YNA + (size_t)tok * 512 + lane * 8);
                float v[8] = {bflo(w.x), bfhi(w.x), bflo(w.y), bfhi(w.y), bflo(w.z), bfhi(w.z), bflo(w.w), bfhi(w.w)}; float s = 0.f;
#pragma unroll
                for (int j = 0; j < 8; ++j) s += v[j] * v[j];
                const float r = rsqrtf(wave_sum(s) * (1.0f / NAW) + EPS);
                v4u o; o.x = pk2(v[0] * r, v[1] * r); o.y = pk2(v[2] * r, v[3] * r); o.z = pk2(v[4] * r, v[5] * r); o.w = pk2(v[6] * r, v[7] * r);
                *(v4u*)(MIX + (size_t)tok * DM + 512 + lane * 8) = o; }
#endif
        }
    }
}

__device__ __forceinline__ void router_naive(Frame& F) {
    const bf16* H1 = WSP(bf16, WS_H1); const float* WR = WSP(float, WS_WR); float* rs1 = WSP(float, WS_RS1); float* GATE = WSP(float, WS_GATE); int* LIST = WSP(int, WS_LIST);
    const float* bg = F.in[20]; const float* be = F.in[22];
    const int gw = F.vcu * NWAVES + F.wave, NGW = F.G * NWAVES, lane = F.lane;
    for (int tok = gw; tok < M; tok += NGW) {
        const v4u wa = *(const v4u*)(H1 + (size_t)tok * DM + lane * 8), wb = *(const v4u*)(H1 + (size_t)tok * DM + 512 + lane * 8);
        float xv[16] = {bflo(wa.x), bfhi(wa.x), bflo(wa.y), bfhi(wa.y), bflo(wa.z), bfhi(wa.z), bflo(wa.w), bfhi(wa.w), bflo(wb.x), bfhi(wb.x), bflo(wb.y), bfhi(wb.y), bflo(wb.z), bfhi(wb.z), bflo(wb.w), bfhi(wb.w)};
        float ss = 0.f;
#pragma unroll
        for (int i = 0; i < 16; ++i) ss += xv[i] * xv[i];
        const float rstd = rsqrtf(wave_sum(ss) * (1.0f / DM) + EPS);
        if (lane == 0) rs1[tok] = rstd;
        float mylg = 0.f;
#pragma nounroll
        for (int j = 0; j < 36; ++j) {
            const f32x4 w0 = *(const f32x4*)(WR + j * 1024 + lane * 8), w1 = *(const f32x4*)(WR + j * 1024 + lane * 8 + 4), w2 = *(const f32x4*)(WR + j * 1024 + 512 + lane * 8), w3 = *(const f32x4*)(WR + j * 1024 + 512 + lane * 8 + 4);
            float a = xv[0] * w0[0] + xv[1] * w0[1] + xv[2] * w0[2] + xv[3] * w0[3] + xv[4] * w1[0] + xv[5] * w1[1] + xv[6] * w1[2] + xv[7] * w1[3]
                    + xv[8] * w2[0] + xv[9] * w2[1] + xv[10] * w2[2] + xv[11] * w2[3] + xv[12] * w3[0] + xv[13] * w3[1] + xv[14] * w3[2] + xv[15] * w3[3];
            const float sm = wave_sum(a) * rstd + (j < 4 ? bg[j] : be[j - 4]);
            if (lane == j) mylg = sm;
        }
        float lg[4];
#pragma unroll
        for (int j = 0; j < 4; ++j) lg[j] = __shfl(mylg, j);
        int g = 0; float gm = lg[0];
#pragma unroll
        for (int j = 1; j < 4; ++j) if (lg[j] > gm) { gm = lg[j]; g = j; }
        float gz = 0.f;
#pragma unroll
        for (int j = 0; j < 4; ++j) gz += __expf(lg[j] - gm);
        const float g_w = 1.f / gz;
        float e8[8];
#pragma unroll
        for (int i = 0; i < 8; ++i) e8[i] = __shfl(mylg, 4 + g * 8 + i);
        int i0 = 0; float m0 = e8[0];
#pragma unroll
        for (int i = 1; i < 8; ++i) if (e8[i] > m0) { m0 = e8[i]; i0 = i; }
        int i1 = -1; float m1 = -3.0e38f;
#pragma unroll
        for (int i = 0; i < 8; ++i) if (i != i0 && e8[i] > m1) { m1 = e8[i]; i1 = i; }
        const float r = __expf(m1 - m0); const float gate0 = g_w / (1.f + r), gate1 = g_w * r / (1.f + r);
        if (lane == 0) {
            const int e0 = g * 8 + i0, e1 = g * 8 + i1;
            const unsigned s0 = atomicAdd((unsigned*)(F.ctl + CW_CNT + 64 * e0), 1u); LIST[(size_t)e0 * LCAP + s0] = tok * 2; GATE[tok * 2] = gate0;
            const unsigned s1 = atomicAdd((unsigned*)(F.ctl + CW_CNT + 64 * e1), 1u); LIST[(size_t)e1 * LCAP + s1] = tok * 2 + 1; GATE[tok * 2 + 1] = gate1;
        }
    }
}

__device__ __forceinline__ float siluf_(float v) { return v / (1.f + __expf(-v)); }
__device__ __forceinline__ void moe_naive(Frame& F) {
    LAS int* tab = (LAS int*)(F.lds + TAB_OFF);
    LAS float* xs = (LAS float*)F.lds;
    LAS float* hs = xs + 8 * 1024;
    LAS int* tk = (LAS int*)(hs + 8 * 512);
    const bf16* H1 = WSP(bf16, WS_H1); const float* rs1 = WSP(float, WS_RS1); const float* GATE = WSP(float, WS_GATE); const int* LIST = WSP(int, WS_LIST);
    const bf16* W13 = WSP(bf16, WS_W13); const bf16* W2 = WSP(bf16, WS_W2); bf16* YK0 = WSP(bf16, WS_YK0); bf16* YK1 = WSP(bf16, WS_YK1);
    const int tid = F.tid;
    __syncthreads();
    if (tid < NE) tab[40 + tid] = (int)__hip_atomic_load(F.ctl + CW_CNT + 64 * tid, RLX_AGENT);
    __syncthreads();
    if (tid == 0) { int s = 0; for (int e = 0; e < NE; ++e) { tab[e] = s; s += (tab[40 + e] + 7) >> 3; } tab[NE] = s; }
    __syncthreads();
    const int total = tab[NE];
    for (int unit = blockIdx.x; unit < total; unit += F.G) {
        int e = 0;
        for (int j = 1; j < NE; ++j) if (tab[j] <= unit) e = j;
        const int ch = unit - tab[e], ne = tab[40 + e];
        __syncthreads();
        if (tid < 8) { const int idx = ch * 8 + tid; tk[tid] = idx < ne ? LIST[(size_t)e * LCAP + idx] : -1; }
        __syncthreads();
        for (int i = tid; i < 8 * 1024; i += 512) { const int r = i >> 10, k = i & 1023; const int t = tk[r]; xs[i] = t >= 0 ? bf2f(H1[(size_t)(t >> 1) * DM + k]) : 0.f; }
        __syncthreads();
        {
            const int c1 = (tid >> 2) * 8 + (tid & 3);
            const bf16* w1r = W13 + ((size_t)e * 1024 + c1) * DM; const bf16* w3r = w1r + 4 * DM;
            float a1[8], a3[8];
#pragma unroll
            for (int r = 0; r < 8; ++r) { a1[r] = 0.f; a3[r] = 0.f; }
            for (int k8 = 0; k8 < 128; ++k8) {
                const v4u u1 = *(const v4u*)(w1r + k8 * 8), u3 = *(const v4u*)(w3r + k8 * 8);
                const float p1[8] = {bflo(u1.x), bfhi(u1.x), bflo(u1.y), bfhi(u1.y), bflo(u1.z), bfhi(u1.z), bflo(u1.w), bfhi(u1.w)};
                const float p3[8] = {bflo(u3.x), bfhi(u3.x), bflo(u3.y), bfhi(u3.y), bflo(u3.z), bfhi(u3.z), bflo(u3.w), bfhi(u3.w)};
#pragma unroll
                for (int r = 0; r < 8; ++r) { const f32x4 xa = *(const LAS f32x4*)(xs + r * 1024 + k8 * 8), xb = *(const LAS f32x4*)(xs + r * 1024 + k8 * 8 + 4);
                    a1[r] += xa[0] * p1[0] + xa[1] * p1[1] + xa[2] * p1[2] + xa[3] * p1[3] + xb[0] * p1[4] + xb[1] * p1[5] + xb[2] * p1[6] + xb[3] * p1[7];
                    a3[r] += xa[0] * p3[0] + xa[1] * p3[1] + xa[2] * p3[2] + xa[3] * p3[3] + xb[0] * p3[4] + xb[1] * p3[5] + xb[2] * p3[6] + xb[3] * p3[7]; }
            }
#pragma unroll
            for (int r = 0; r < 8; ++r) { const int t = tk[r]; const float rs = t >= 0 ? rs1[t >> 1] : 0.f; hs[r * 512 + tid] = bfr(siluf_(a1[r] * rs) * (a3[r] * rs)); }
        }
        __syncthreads();
#pragma unroll
        for (int cc = 0; cc < 2; ++cc) { const int c = tid * 2 + cc; const bf16* w2r = W2 + ((size_t)e * DM + c) * DE;
            float a[8];
#pragma unroll
            for (int r = 0; r < 8; ++r) a[r] = 0.f;
            for (int k8 = 0; k8 < 64; ++k8) { const v4u u = *(const v4u*)(w2r + k8 * 8);
                const float p[8] = {bflo(u.x), bfhi(u.x), bflo(u.y), bfhi(u.y), bflo(u.z), bfhi(u.z), bflo(u.w), bfhi(u.w)};
#pragma unroll
                for (int r = 0; r < 8; ++r) { const f32x4 xa = *(const LAS f32x4*)(hs + r * 512 + k8 * 8), xb = *(const LAS f32x4*)(hs + r * 512 + k8 * 8 + 4);
                    a[r] += xa[0] * p[0] + xa[1] * p[1] + xa[2] * p[2] + xa[3] * p[3] + xb[0] * p[4] + xb[1] * p[5] + xb[2] * p[6] + xb[3] * p[7]; } }
#pragma unroll
            for (int r = 0; r < 8; ++r) { const int t = tk[r]; if (t >= 0) { bf16* Y = (t & 1) ? YK1 : YK0; Y[(size_t)(t >> 1) * DM + c] = (bf16)f2bf(a[r] * GATE[t]); } }
        }
    }
}

__device__ __forceinline__ void combine(Frame& F) {
    const bf16* H1 = WSP(bf16, WS_H1); const bf16* Y0 = WSP(bf16, WS_YK0); const bf16* Y1 = WSP(bf16, WS_YK1); bf16* H2 = WSP(bf16, WS_H2); float* rs2 = WSP(float, WS_RS2);
    const int gw = F.vcu * NWAVES + F.wave, NGW = F.G * NWAVES, lane = F.lane;
    for (int tok = gw; tok < M; tok += NGW) {
        float ss = 0.f;
#pragma unroll
        for (int hh = 0; hh < 2; ++hh) { const size_t o = (size_t)tok * DM + hh * 512 + lane * 8;
            const v4u a = *(const v4u*)(H1 + o), b = *(const v4u*)(Y0 + o), c = *(const v4u*)(Y1 + o);
            float v[8] = {bflo(a.x) + bflo(b.x) + bflo(c.x), bfhi(a.x) + bfhi(b.x) + bfhi(c.x), bflo(a.y) + bflo(b.y) + bflo(c.y), bfhi(a.y) + bfhi(b.y) + bfhi(c.y),
                          bflo(a.z) + bflo(b.z) + bflo(c.z), bfhi(a.z) + bfhi(b.z) + bfhi(c.z), bflo(a.w) + bflo(b.w) + bflo(c.w), bfhi(a.w) + bfhi(b.w) + bfhi(c.w)};
            v4u w; w.x = pk2(v[0], v[1]); w.y = pk2(v[2], v[3]); w.z = pk2(v[4], v[5]); w.w = pk2(v[6], v[7]);
            *(v4u*)(H2 + o) = w;
            const float q[8] = {bflo(w.x), bfhi(w.x), bflo(w.y), bfhi(w.y), bflo(w.z), bfhi(w.z), bflo(w.w), bfhi(w.w)};
#pragma unroll
            for (int j = 0; j < 8; ++j) ss += q[j] * q[j]; }
        ss = wave_sum(ss);
        if (lane == 0) rs2[tok] = rsqrtf(ss * (1.0f / DM) + EPS);
    }
}
__device__ __forceinline__ void final_norm(Frame& F) {
    const bf16* H3 = WSP(bf16, WS_H3); const float* gf = F.in[29]; float* out = F.out;
    const int gw = F.vcu * NWAVES + F.wave, NGW = F.G * NWAVES, lane = F.lane;
    for (int tok = gw; tok < M; tok += NGW) {
        float v[16]; float ss = 0.f;
#pragma unroll
        for (int hh = 0; hh < 2; ++hh) { const v4u a = *(const v4u*)(H3 + (size_t)tok * DM + hh * 512 + lane * 8);
            v[hh * 8 + 0] = bflo(a.x); v[hh * 8 + 1] = bfhi(a.x); v[hh * 8 + 2] = bflo(a.y); v[hh * 8 + 3] = bfhi(a.y); v[hh * 8 + 4] = bflo(a.z); v[hh * 8 + 5] = bfhi(a.z); v[hh * 8 + 6] = bflo(a.w); v[hh * 8 + 7] = bfhi(a.w); }
#pragma unroll
        for (int j = 0; j < 16; ++j) ss += v[j] * v[j];
        const float r = rsqrtf(wave_sum(ss) * (1.0f / DM) + EPS);
#pragma unroll
        for (int hh = 0; hh < 2; ++hh) { const int c0 = hh * 512 + lane * 8; const f32x4 g0 = *(const f32x4*)(gf + c0), g1 = *(const f32x4*)(gf + c0 + 4);
            f32x4 o0 = {v[hh * 8 + 0] * r * g0[0], v[hh * 8 + 1] * r * g0[1], v[hh * 8 + 2] * r * g0[2], v[hh * 8 + 3] * r * g0[3]};
            f32x4 o1 = {v[hh * 8 + 4] * r * g1[0], v[hh * 8 + 5] * r * g1[1], v[hh * 8 + 6] * r * g1[2], v[hh * 8 + 7] * r * g1[3]};
            *(f32x4*)(out + (size_t)tok * DM + c0) = o0; *(f32x4*)(out + (size_t)tok * DM + c0 + 4) = o1; }
    }
}
typedef float f32x16 __attribute__((ext_vector_type(16)));
constexpr size_t WS_WRB = WS_WR + 160 * KiB;

__device__ __forceinline__ void p0_router_weights_bf16(Frame& F) {
    bf16* WRB = WSP(bf16, WS_WRB); const float* g_ffn = F.in[18];
    for (int i = blockIdx.x * 512 + F.tid; i < 48 * 1024; i += F.G * 512) { const int w = i >> 10, k = i & 1023, nt = w >> 4, g = (w >> 2) & 3, reg = w & 3;
        const float v = (nt < 2 ? F.in[21][k * 32 + g * 8 + 4 * nt + reg] : F.in[19][k * 4 + reg]) * g_ffn[k];
        WRB[i] = (bf16)f2bf(v); }
}
__device__ __forceinline__ void router_mfma(Frame& F, const int alt = 0) {
    const bf16* H1 = WSP(bf16, WS_H1); const bf16* WRB = WSP(bf16, WS_WRB); float* rs1 = alt ? WSP(float, WS_RS2) : WSP(float, WS_RS1); float* GATE = alt ? WSP(float, WS_GATE + 512 * KiB) : WSP(float, WS_GATE); int* LIST = alt ? WSP(int, 480 * MiB) : WSP(int, WS_LIST);
    const int cw_cnt = alt ? CW_CNT + 4096 : CW_CNT;
    const float* bg = F.in[20]; const float* be = F.in[22];
    LAS int* lcnt = (LAS int*)(F.lds + TAB_OFF); LAS int* lbase = lcnt + 32;
    const int lane = F.lane, j = lane & 15, g = lane >> 4;
    constexpr int WP = 2064;
    LAS unsigned char* WL = F.lds;
    __syncthreads();
    for (int i = F.tid; i < 48 * 128; i += 512) { const int row = i >> 7, ch = i & 127; *(LAS v4u*)(WL + row * WP + ch * 16) = *(const v4u*)(WRB + (size_t)row * DM + ch * 8); }
    __syncthreads();
    const int ntask = M / 16, per = F.G * NWAVES, niter = (ntask + per - 1) / per;
    for (int it = 0; it < niter; ++it) {
        const int task = (it * F.G + blockIdx.x) * NWAVES + F.wave; const bool live = task < ntask;
        __syncthreads();
        if (F.tid < 32) lcnt[F.tid] = 0;
        __syncthreads();
        int e0 = 0, e1 = 0, r0 = 0, r1 = 0, tok = 0; float gate0 = 0.f, gate1 = 0.f; bool mine = false;
        if (live) {
            tok = task * 16 + j;
            const bf16* hrow = H1 + (size_t)tok * DM + 8 * g; const LAS unsigned char* wrow = WL + j * WP + 16 * g;
            f32x4 acc[3] = {{0.f, 0.f, 0.f, 0.f}, {0.f, 0.f, 0.f, 0.f}, {0.f, 0.f, 0.f, 0.f}}; float ss = 0.f;
#pragma unroll 8
            for (int kk = 0; kk < 32; ++kk) {
                const v4u hb = *(const v4u*)(hrow + 32 * kk);
                const bf16x8 bfrag = __builtin_bit_cast(bf16x8, hb);
                ss += bflo(hb.x) * bflo(hb.x) + bfhi(hb.x) * bfhi(hb.x) + bflo(hb.y) * bflo(hb.y) + bfhi(hb.y) * bfhi(hb.y) + bflo(hb.z) * bflo(hb.z) + bfhi(hb.z) * bfhi(hb.z) + bflo(hb.w) * bflo(hb.w) + bfhi(hb.w) * bfhi(hb.w);
#pragma unroll
                for (int nt = 0; nt < 3; ++nt) { const bf16x8 afrag = *(const LAS bf16x8*)(wrow + nt * 16 * WP + 64 * kk);
                    acc[nt] = __builtin_amdgcn_mfma_f32_16x16x32_bf16(afrag, bfrag, acc[nt], 0, 0, 0); }
            }
            ss += __shfl_xor(ss, 16); ss += __shfl_xor(ss, 32);
            const float rstd = rsqrtf(ss * (1.0f / DM) + EPS);
            if (g == 0) rs1[tok] = rstd;
            float gl[4], e8[8];
#pragma unroll
            for (int r = 0; r < 4; ++r) { gl[r] = acc[2][r] * rstd + bg[r]; e8[r] = acc[0][r] * rstd + be[g * 8 + r]; e8[4 + r] = acc[1][r] * rstd + be[g * 8 + 4 + r]; }
            int gs = 0; float gm = gl[0];
#pragma unroll
            for (int r = 1; r < 4; ++r) if (gl[r] > gm) { gm = gl[r]; gs = r; }
            float gz = 0.f;
#pragma unroll
            for (int r = 0; r < 4; ++r) gz += __expf(gl[r] - gm);
            const float g_w = 1.f / gz;
            int i0 = 0; float m0 = e8[0];
#pragma unroll
            for (int i = 1; i < 8; ++i) if (e8[i] > m0) { m0 = e8[i]; i0 = i; }
            int i1 = -1; float m1 = -3.0e38f;
#pragma unroll
            for (int i = 0; i < 8; ++i) if (i != i0 && e8[i] > m1) { m1 = e8[i]; i1 = i; }
            const float rr = __expf(m1 - m0); gate0 = g_w / (1.f + rr); gate1 = g_w * rr / (1.f + rr);
            mine = (g == gs); e0 = g * 8 + i0; e1 = g * 8 + i1;
            if (mine) { r0 = __hip_atomic_fetch_add(lcnt + e0, 1, __ATOMIC_RELAXED, __HIP_MEMORY_SCOPE_WORKGROUP); r1 = __hip_atomic_fetch_add(lcnt + e1, 1, __ATOMIC_RELAXED, __HIP_MEMORY_SCOPE_WORKGROUP); }
        }
        __syncthreads();
        if (F.tid < 32) { const int n = lcnt[F.tid]; lbase[F.tid] = n > 0 ? (int)atomicAdd((unsigned*)(F.ctl + cw_cnt + 64 * F.tid), (unsigned)n) : 0; }
        __syncthreads();
        if (mine) {
            LIST[(size_t)e0 * LCAP + lbase[e0] + r0] = tok * 2; GATE[tok * 2] = gate0;
            LIST[(size_t)e1 * LCAP + lbase[e1] + r1] = tok * 2 + 1; GATE[tok * 2 + 1] = gate1;
        }
    }
}

__device__ __forceinline__ void moe_table(Frame& F, LAS int* tab) {
    __syncthreads();
    if (F.tid < NE) tab[40 + F.tid] = (int)__hip_atomic_load(F.ctl + CW_CNT + 64 * F.tid, RLX_AGENT);
    __syncthreads();
    if (F.tid == 0) { int s = 0; for (int e = 0; e < NE; ++e) { tab[e] = s; s += (tab[40 + e] + 255) >> 8; } tab[NE] = s; }
    __syncthreads();
}
template <bool GATHER>
struct MoeSrc {
    const LAS int* tab; int G, c, ntiles, K;
    const char* A; const char* B; size_t estepB, tstepB, tstepA; const int* LIST;
    __device__ __forceinline__ bool next(int i, pg8::Unit& u) const {
        const int L = i * G + c; if (L >= ntiles * 4) return false;
        const int tile = L >> 2; int e = 0;
        for (int jj = 1; jj < NE; ++jj) if (tab[jj] <= tile) e = jj;
        e = __builtin_amdgcn_readfirstlane(e);
        u.pm = tile; u.pn = L & 3; u.e = e; u.aux = tile - __builtin_amdgcn_readfirstlane(tab[e]); return true;
    }
    __device__ __forceinline__ const char* abase(const pg8::Unit& u) const { return GATHER ? A : A + (size_t)u.pm * tstepA; }
    __device__ __forceinline__ const char* bbase(const pg8::Unit& u) const { return B + (size_t)u.e * estepB + (size_t)u.pn * tstepB; }
    __device__ __forceinline__ void aoff(const pg8::Unit& u, int K_, const int (&R)[2], const int (&C)[2], unsigned (&off)[2][2]) const {
        if constexpr (GATHER) {
            const int ne = tab[40 + u.e]; const int* lst = LIST + (size_t)u.e * LCAP;
#pragma unroll
            for (int h = 0; h < 2; ++h)
#pragma unroll
                for (int i = 0; i < 2; ++i) { const int r = u.aux * 256 + 128 * h + R[i]; const int t = lst[r < ne ? r : 0];
                    off[h][i] = (unsigned)(t >> 1) * (unsigned)(K_ * 2) + (unsigned)C[i] * 2u; }
        } else {
#pragma unroll
            for (int h = 0; h < 2; ++h)
#pragma unroll
                for (int i = 0; i < 2; ++i) off[h][i] = (unsigned)((128 * h + R[i]) * K_ + C[i]) * 2u;
        }
    }
};
struct EpiM1 {
    static constexpr bool PERM = true;
    bf16* HID; const int* LIST; const float* rs1; const LAS int* tab;
    __device__ __forceinline__ void operator()(const f32x4 (&acc)[2][2][4][2], const Unit& u, int wr, int wc, int fr, int fq) const {
        const int ne = tab[40 + u.e]; const int* lst = LIST + (size_t)u.e * LCAP;
        const int hc0 = u.pn * 128 + wc * 16 + 4 * fq;
#pragma unroll
        for (int ai = 0; ai < 2; ++ai)
#pragma unroll
            for (int m = 0; m < 4; ++m) { const int rl = ai * 128 + wr * 64 + m * 16 + fr, r = u.aux * 256 + rl;
                float rs = 0.f; if (r < ne) rs = rs1[lst[r] >> 1];
                bf16* rowp = HID + (size_t)(u.pm * 256 + rl) * DE + hc0;
#pragma unroll
                for (int bj = 0; bj < 2; ++bj) { const f32x4 a1 = acc[ai][bj][m][0] * rs, a3 = acc[ai][bj][m][1] * rs;
                    float hv[4];
#pragma unroll
                    for (int i = 0; i < 4; ++i) hv[i] = a1[i] / (1.f + __expf(-a1[i])) * a3[i];
                    v2u w; w.x = pg8::cvt_pk_bf16(hv[0], hv[1]); w.y = pg8::cvt_pk_bf16(hv[2], hv[3]);
                    *(v2u*)(rowp + bj * 64) = w; } }
    }
};
struct EpiM2 {
    static constexpr bool PERM = true;
    bf16* Y0; long ydelta; const int* LIST; const float* GATE; const LAS int* tab;
    __device__ __forceinline__ void operator()(const f32x4 (&acc)[2][2][4][2], const Unit& u, int wr, int wc, int fr, int fq) const {
        const int ne = tab[40 + u.e]; const int* lst = LIST + (size_t)u.e * LCAP;
        const int col0 = u.pn * 256 + wc * 32 + 8 * fq;
#pragma unroll
        for (int ai = 0; ai < 2; ++ai)
#pragma unroll
            for (int m = 0; m < 4; ++m) { const int r = u.aux * 256 + ai * 128 + wr * 64 + m * 16 + fr;
                if (r < ne) { const int t = lst[r]; const float gt = GATE[t]; bf16* rowp = Y0 + (long)(t & 1) * ydelta + (size_t)(t >> 1) * DM + col0;
#pragma unroll
                    for (int bj = 0; bj < 2; ++bj) { const f32x4 v0 = acc[ai][bj][m][0] * gt, v1 = acc[ai][bj][m][1] * gt;
                        v4u w; w.x = pg8::cvt_pk_bf16(v0[0], v0[1]); w.y = pg8::cvt_pk_bf16(v0[2], v0[3]); w.z = pg8::cvt_pk_bf16(v1[0], v1[1]); w.w = pg8::cvt_pk_bf16(v1[2], v1[3]);
                        *(v4u*)(rowp + bj * 128) = w; } } }
    }
};
#ifndef PG8_SP2
#define PG8_SP2 true
#endif
#ifndef PG8_ALIGN
#define PG8_ALIGN true
#endif
__device__ __forceinline__ void moe_gemm1(Frame& F) {
    LAS int* tab = (LAS int*)(F.lds + TAB_OFF);
    moe_table(F, tab);
    MoeSrc<true> S; S.tab = tab; S.G = F.G; S.c = (int)blockIdx.x; S.ntiles = __builtin_amdgcn_readfirstlane(tab[NE]); S.K = DM;
    S.A = (const char*)WSP(bf16, WS_H1); S.B = (const char*)WSP(bf16, WS_W13); S.estepB = (size_t)1024 * DM * 2; S.tstepB = (size_t)256 * DM * 2; S.tstepA = 0; S.LIST = WSP(int, WS_LIST);
    EpiM1 E{WSP(bf16, WS_HID), WSP(int, WS_LIST), WSP(float, WS_RS1), tab};
    pg8::gemm_phase<EpiM1, MoeSrc<true>, true, true, PG8_ALIGN, PG8_SP2>(F.lds + RING_OFF, DM, S, E);
}
__device__ __forceinline__ void moe_gemm2(Frame& F) {
    LAS int* tab = (LAS int*)(F.lds + TAB_OFF);
    moe_table(F, tab);
    MoeSrc<false> S; S.tab = tab; S.G = F.G; S.c = (int)blockIdx.x; S.ntiles = __builtin_amdgcn_readfirstlane(tab[NE]); S.K = DE;
    S.A = (const char*)WSP(bf16, WS_HID); S.B = (const char*)WSP(bf16, WS_W2); S.estepB = (size_t)DM * DE * 2; S.tstepB = (size_t)256 * DE * 2; S.tstepA = (size_t)256 * DE * 2; S.LIST = WSP(int, WS_LIST);
    EpiM2 E{WSP(bf16, WS_YK0), (long)((WS_YK1 - WS_YK0) / 2), WSP(int, WS_LIST), WSP(float, WS_GATE), tab};
    pg8::gemm_phase<EpiM2, MoeSrc<false>, true, false, PG8_ALIGN, PG8_SP2>(F.lds + RING_OFF, DE, S, E);
}

constexpr int HY_ZP = 4112, HY_CP = 8208, HY_GC_OFF = 16 * HY_ZP;
static_assert(HY_GC_OFF + 16 * HY_ZP <= SCRATCH_BYTES && 8 * HY_CP <= 16 * HY_ZP, "hyena LDS");
__device__ __forceinline__ void hy_row_load(const bf16* row, int tid, v4u (&r)[8]) {
#pragma unroll
    for (int it = 0; it < 8; ++it) r[it] = *(const v4u*)(row + (size_t)(it * 512 + tid) * 8);
}
__device__ __forceinline__ void hy_row_store(LAS unsigned char* dst, int tid, const v4u (&r)[8]) {
#pragma unroll
    for (int it = 0; it < 8; ++it) { const int idx = it * 512 + tid, b = idx >> 8, s0 = (idx & 255) * 8; *(LAS v4u*)(dst + b * HY_ZP + s0 * 2) = r[it]; }
}
__device__ __forceinline__ void hy_expand(LAS unsigned char* GC, int tid, const v4u lo, const v4u hi) {
    const unsigned d[8] = {lo.x, lo.y, lo.z, lo.w, hi.x, hi.y, hi.z, hi.w};
#pragma unroll
    for (int rho = 0; rho < 8; ++rho) { const int j = rho >> 1; v4u q;
        if (rho & 1) { q.x = (d[j] >> 16) | (d[j + 1] << 16); q.y = (d[j + 1] >> 16) | (d[j + 2] << 16); q.z = (d[j + 2] >> 16) | (d[j + 3] << 16); q.w = (d[j + 3] >> 16) | (d[j + 4] << 16); }
        else { q.x = d[j]; q.y = d[j + 1]; q.z = d[j + 2]; q.w = d[j + 3]; }
        *(LAS v4u*)(GC + rho * HY_CP + tid * 16) = q; }
}
__device__ __forceinline__ void hy_prepass(LAS unsigned char* RAW, LAS unsigned char* ZB, int tid, float w0, float w1, float w2, float cb) {
#pragma unroll 2
    for (int it = 0; it < 8; ++it) { const int idx = it * 512 + tid, b = idx >> 8, s0 = (idx & 255) * 8;
        const LAS unsigned char* u = RAW + b * HY_ZP + s0 * 2;
        const v4u x8 = *(const LAS v4u*)u;
        float x[10]; x[0] = s0 > 0 ? bf2f(*(const LAS bf16*)(u - 2)) : 0.f; x[9] = s0 + 8 < SEQ ? bf2f(*(const LAS bf16*)(u + 16)) : 0.f;
        x[1] = bflo(x8.x); x[2] = bfhi(x8.x); x[3] = bflo(x8.y); x[4] = bfhi(x8.y); x[5] = bflo(x8.z); x[6] = bfhi(x8.z); x[7] = bflo(x8.w); x[8] = bfhi(x8.w);
        float o8[8];
#pragma unroll
        for (int i = 0; i < 8; ++i) o8[i] = cb + w0 * x[i] + w1 * x[i + 1] + w2 * x[i + 2];
        v4u o; o.x = pk2(o8[0], o8[1]); o.y = pk2(o8[2], o8[3]); o.z = pk2(o8[4], o8[5]); o.w = pk2(o8[6], o8[7]);
        *(LAS v4u*)(ZB + b * HY_ZP + s0 * 2) = o; }
}
template <int O>
__device__ __forceinline__ void hyena_order(Frame& F, int c, int cn, LAS unsigned char* ZB, LAS unsigned char* GC, int abase, int bbase, v4u& glo, v4u& ghi, v4u (&vnext)[8]) {
    constexpr int ZP = HY_ZP;
    const bf16* UT = WSP(bf16, WS_UT); const bf16* HYK = WSP(bf16, WS_HYK); bf16* YT = WSP(bf16, WS_YT);
    const float* cw = F.in[4]; const float* cbv = F.in[5]; const float* skip = F.in[13];
    const int tid = F.tid, lane = F.lane, w = F.wave, r = lane & 15, g = lane >> 4;
    const int gc = O ? 512 + c : c;
    { const bf16* Gn = HYK + (size_t)(O == 0 ? 512 + c : cn) * GSTR; glo = *(const v4u*)(Gn + 8 * tid); ghi = *(const v4u*)(Gn + 8 * tid + 8); }
    f32x4 acc[16]; bf16x8 W[16];
#pragma unroll
    for (int i = 0; i < 16; ++i) { acc[i] = (f32x4){0.f, 0.f, 0.f, 0.f}; W[i] = *(const LAS bf16x8*)(GC + abase - 32 * i); }
    bf16x8 bcur = *(const LAS bf16x8*)(ZB + bbase);
#pragma nounroll
    for (int jo = 0; jo < 8; ++jo) {
#pragma unroll
        for (int jj = 0; jj < 8; ++jj) {
            const int J = jo * 8 + jj, Jn = J < 63 ? J + 1 : 63;
            const bf16x8 bnext = *(const LAS bf16x8*)(ZB + bbase + 64 * Jn);
            acc[14] = __builtin_amdgcn_mfma_f32_16x16x32_bf16(W[(14 - 2 * jj) & 15], bcur, acc[14], 0, 0, 0);
            acc[15] = __builtin_amdgcn_mfma_f32_16x16x32_bf16(W[(15 - 2 * jj) & 15], bcur, acc[15], 0, 0, 0);
            W[(-2 * (jj + 1)) & 15] = *(const LAS bf16x8*)(GC + abase + 64 * Jn);
            W[(-2 * (jj + 1) + 1) & 15] = *(const LAS bf16x8*)(GC + abase + 64 * Jn - 32);
#pragma unroll
            for (int I = 2; I < 14; ++I) acc[I] = __builtin_amdgcn_mfma_f32_16x16x32_bf16(W[(I - 2 * jj) & 15], bcur, acc[I], 0, 0, 0);
            acc[0] = __builtin_amdgcn_mfma_f32_16x16x32_bf16(W[(0 - 2 * jj) & 15], bcur, acc[0], 0, 0, 0);
            acc[1] = __builtin_amdgcn_mfma_f32_16x16x32_bf16(W[(1 - 2 * jj) & 15], bcur, acc[1], 0, 0, 0);
            bcur = bnext;
            __builtin_amdgcn_sched_barrier(0);
        }
    }
    v4u gate[8];
    hy_row_load(UT + (size_t)gc * M, tid, gate);
    __syncthreads();
    if constexpr (O == 1) hy_row_load(UT + (size_t)(1024 + cn) * M, tid, vnext);
    hy_row_store(GC, tid, gate);
    __syncthreads();
    {
        const float w0 = cw[gc], w1 = cw[1536 + gc], w2 = cw[3072 + gc], cb = cbv[gc], sk = skip[O * 512 + c];
#pragma unroll
        for (int I = 0; I < 16; ++I) { const int t0 = 256 * w + 16 * I + 4 * g;
            const v2u zo = *(const LAS v2u*)(ZB + r * ZP + t0 * 2);
            const LAS unsigned char* u = GC + r * ZP + t0 * 2;
            const v2u x4 = *(const LAS v2u*)u;
            float x[6]; x[0] = t0 > 0 ? bf2f(*(const LAS bf16*)(u - 2)) : 0.f; x[5] = t0 + 4 < SEQ ? bf2f(*(const LAS bf16*)(u + 8)) : 0.f;
            x[1] = bflo(x4.x); x[2] = bfhi(x4.x); x[3] = bflo(x4.y); x[4] = bfhi(x4.y);
            const float zz[4] = {bflo(zo.x), bfhi(zo.x), bflo(zo.y), bfhi(zo.y)};
            float ov[4];
#pragma unroll
            for (int i = 0; i < 4; ++i) ov[i] = (cb + w0 * x[i] + w1 * x[i + 1] + w2 * x[i + 2]) * (acc[I][i] + zz[i] * sk);
            v2u q; q.x = pk2(ov[0], ov[1]); q.y = pk2(ov[2], ov[3]);
            if constexpr (O == 0) *(LAS v2u*)(ZB + r * ZP + t0 * 2) = q;
            else *(v2u*)(YT + (size_t)c * M + r * SEQ + t0) = q; }
    }
    __syncthreads();
}
__device__ __forceinline__ void hyena_mfma(Frame& F) {
    constexpr int ZP = HY_ZP, CP = HY_CP;
    LAS unsigned char* ZB = F.lds; LAS unsigned char* GC = F.lds + HY_GC_OFF;
    const bf16* UT = WSP(bf16, WS_UT); const bf16* HYK = WSP(bf16, WS_HYK);
    const float* cw = F.in[4]; const float* cbv = F.in[5];
    const int tid = F.tid, lane = F.lane, w = F.wave, r = lane & 15, g = lane >> 4;
    const int rho_l = (8 - (r & 7)) & 7;
    const int abase = rho_l * CP + (2048 - r + 8 * g - rho_l) * 2 - 512 * w;
    const int bbase = r * ZP + 16 * g;
#ifndef HY_REP
#define HY_REP 1
#endif
    int cc = blockIdx.x, c = cc % HYW;
    if (cc >= HYW * HY_REP) return;
    v4u glo, ghi, vrow[8];
    __syncthreads();
    hy_row_load(UT + (size_t)(1024 + c) * M, tid, vrow);
    { const bf16* G0 = HYK + (size_t)c * GSTR; glo = *(const v4u*)(G0 + 8 * tid); ghi = *(const v4u*)(G0 + 8 * tid + 8); }
    for (; cc < HYW * HY_REP; cc += F.G) {
        c = cc % HYW; const int cn = cc + F.G < HYW * HY_REP ? (cc + F.G) % HYW : c;
        hy_row_store(GC, tid, vrow);
        __syncthreads();
        hy_prepass(GC, ZB, tid, cw[1024 + c], cw[1536 + 1024 + c], cw[3072 + 1024 + c], cbv[1024 + c]);
        __syncthreads();
        hy_expand(GC, tid, glo, ghi);
        __syncthreads();
        hyena_order<0>(F, c, cn, ZB, GC, abase, bbase, glo, ghi, vrow);
        hy_expand(GC, tid, glo, ghi);
        __syncthreads();
        hyena_order<1>(F, c, cn, ZB, GC, abase, bbase, glo, ghi, vrow);
    }
}

__device__ __forceinline__ void natten_mfma(Frame& F) {
    LAS float* RPB = (LAS float*)F.lds;
    LAS float* SS = (LAS float*)(F.lds + 16384);
    const bf16* Q = WSP(bf16, WS_Q); const bf16* Kb = WSP(bf16, WS_K); const bf16* VT = WSP(bf16, WS_UT) + (size_t)1536 * M; bf16* MIX = WSP(bf16, WS_MIX);
    __syncthreads();
    for (int i = F.tid; i < NH * 15 * 31; i += 512) RPB[i] = F.in[14][i] * 1.4426950408889634f;
    __syncthreads();
    const int lane = F.lane, ql = lane & 31, hf = lane >> 5;
    bf16* YNA = WSP(bf16, WS_YNA);
#ifndef NA_REP
#define NA_REP 1
#endif
    for (int uu = F.vcu; uu < NB * 16 * NA_REP; uu += F.G) {
        const int unit = uu % (NB * 16), b = unit >> 4, p = unit & 15;
        const int kr0 = min(min(max(2 * p - 4, 0), 24), 23);
#pragma nounroll
        for (int hi = 0; hi < 4; ++hi) {
            const int j = F.wave & 3, head = (F.wave >> 2) * 4 + hi;
            const int kc0 = j == 0 ? 0 : (j == 1 ? 8 : (j == 2 ? 24 : 32));
            const int qrow = 2 * p + (ql >> 4), qcol = 16 * j + (ql & 15), tq = b * SEQ + qrow * 64 + qcol;
            const int rsq = min(max(qrow - 4, 0), 24), csq = min(max(qcol - 8, 0), 48);
            bf16x8 qf[4];
#pragma unroll
            for (int s = 0; s < 4; ++s) qf[s] = *(const bf16x8*)(Q + (size_t)tq * 512 + head * 64 + 16 * s + 8 * hf);
            const int kql = (ql & 16) | ((ql & 4) << 1) | ((ql & 8) >> 1) | (ql & 3);
            float cmask[16];
#pragma unroll
            for (int rg = 0; rg < 16; ++rg) { const int kcol = kc0 + 16 * (rg >> 3) + 8 * hf + 4 * ((rg >> 2) & 1) + (rg & 3); cmask[rg] = (kcol >= csq && kcol < csq + 16) ? 0.f : -3.0e38f; }
            const LAS float* bcol = RPB + (head * 15 + 7 - qrow) * 31 + (kc0 + 8 * hf - qcol + 15);
            const bf16* kbase = Kb + (size_t)(b * SEQ + kr0 * 64 + kc0 + kql) * 512 + head * 64 + 8 * hf;
            const bf16* vbase = VT + (size_t)(head * 64 + ql) * M + b * SEQ + kr0 * 64 + kc0 + 8 * hf;
            bf16x8 kf[3][4]; bf16x8 vf[3][4];
#define NA_LOAD(buf, i) do { _Pragma("unroll") for (int s = 0; s < 4; ++s) kf[buf][s] = *(const bf16x8*)(kbase + (size_t)(i) * 64 * 512 + 16 * s); \
                _Pragma("unroll") for (int s = 0; s < 2; ++s) _Pragma("unroll") for (int dt = 0; dt < 2; ++dt) vf[buf][s * 2 + dt] = *(const bf16x8*)(vbase + (size_t)dt * 32 * M + (i) * 64 + 16 * s); } while (0)
            NA_LOAD(0, 0); NA_LOAD(1, 1);
            f32x16 O[2];
#pragma unroll
            for (int dt = 0; dt < 2; ++dt) O[dt] = (f32x16){0.f, 0.f, 0.f, 0.f, 0.f, 0.f, 0.f, 0.f, 0.f, 0.f, 0.f, 0.f, 0.f, 0.f, 0.f, 0.f};
            float mx = -1e30f, l = 0.f;
#define NA_TILE(i, cb, pref) do { \
                if (pref) NA_LOAD(((cb) + 2) % 3, (i) + 2); \
                const int krow = kr0 + (i); \
                f32x16 a = {0.f, 0.f, 0.f, 0.f, 0.f, 0.f, 0.f, 0.f, 0.f, 0.f, 0.f, 0.f, 0.f, 0.f, 0.f, 0.f}; \
                _Pragma("unroll") for (int s = 0; s < 4; ++s) a = __builtin_amdgcn_mfma_f32_32x32x16_bf16(kf[cb][s], qf[s], a, 0, 0, 0); \
                const bool rv = krow >= rsq && krow < rsq + 8; \
                const LAS float* brow = bcol + krow * 31; \
                float tm = -3.0e38f; \
                _Pragma("unroll") for (int rg = 0; rg < 16; ++rg) { float sv = a[rg] + (brow[16 * (rg >> 3) + 4 * ((rg >> 2) & 1) + (rg & 3)] + cmask[rg]); sv = rv ? sv : -3.0e38f; a[rg] = sv; tm = fmaxf(tm, sv); } \
                tm = fmaxf(tm, __shfl_xor(tm, 32)); \
                const float mn = fmaxf(mx, tm), alpha = __builtin_amdgcn_exp2f(mx - mn); mx = mn; \
                float ls = 0.f; \
                _Pragma("unroll") for (int rg = 0; rg < 16; ++rg) { const float pv = __builtin_amdgcn_exp2f(a[rg] - mn); a[rg] = pv; ls += pv; } \
                l = l * alpha + ls; \
                _Pragma("unroll") for (int dt = 0; dt < 2; ++dt) O[dt] = O[dt] * alpha; \
                _Pragma("unroll") for (int s = 0; s < 2; ++s) { \
                    v4u pw; pw.x = pg8::cvt_pk_bf16(a[8 * s + 0], a[8 * s + 1]); pw.y = pg8::cvt_pk_bf16(a[8 * s + 2], a[8 * s + 3]); \
                    pw.z = pg8::cvt_pk_bf16(a[8 * s + 4], a[8 * s + 5]); pw.w = pg8::cvt_pk_bf16(a[8 * s + 6], a[8 * s + 7]); \
                    const bf16x8 pf = __builtin_bit_cast(bf16x8, pw); \
                    _Pragma("unroll") for (int dt = 0; dt < 2; ++dt) O[dt] = __builtin_amdgcn_mfma_f32_32x32x16_bf16(vf[cb][s * 2 + dt], pf, O[dt], 0, 0, 0); } \
                __builtin_amdgcn_sched_barrier(0); } while (0)
#pragma nounroll
            for (int ip = 0; ip < 2; ++ip) { NA_TILE(3 * ip, 0, true); NA_TILE(3 * ip + 1, 1, true); NA_TILE(3 * ip + 2, 2, true); }
            NA_TILE(6, 0, true); NA_TILE(7, 1, false); NA_TILE(8, 2, false);
#undef NA_TILE
#undef NA_LOAD
            l += __shfl_xor(l, 32);
            const float inv = 1.f / l;
#pragma unroll
            for (int dt = 0; dt < 2; ++dt)
#pragma unroll
                for (int g4 = 0; g4 < 4; ++g4) { v2u w; w.x = pg8::cvt_pk_bf16(O[dt][4 * g4] * inv, O[dt][4 * g4 + 1] * inv); w.y = pg8::cvt_pk_bf16(O[dt][4 * g4 + 2] * inv, O[dt][4 * g4 + 3] * inv);
                    *(v2u*)(YNA + (size_t)tq * 512 + head * 64 + 32 * dt + 8 * g4 + 4 * hf) = w; }
        }
    }
}
__device__ __forceinline__ void hyena_phase(Frame& F) {
#if HY_NAIVE
    hyena_naive(F);
#else
    hyena_mfma(F);
#endif
}
__device__ __forceinline__ void natten_phase(Frame& F) {
#if NA_NAIVE
    natten_naive(F);
#else
    natten_mfma(F);
#endif
}
__device__ __forceinline__ void router_phase(Frame& F) {
#if RT_NAIVE
    router_naive(F);
#else
    router_mfma(F);
#ifdef RT_TWICE
    router_mfma(F, 1);
#endif
#endif
}
__device__ __forceinline__ void moe_phase_a(Frame& F) {
#if MOE_NAIVE
    moe_naive(F);
#else
    moe_gemm1(F);
#endif
}
__device__ __forceinline__ void moe_phase_b(Frame& F) {
#if MOE_NAIVE
    (void)F;
#else
    moe_gemm2(F);
#endif
}
constexpr int N_PHASES = 11;
constexpr int N_LAUNCHES = MK_N_LAUNCHES;
struct Args { const float* in[30]; float* out; unsigned char* ws; int ph_lo, ph_hi; };
#ifndef PG8_SP2
#define PG8_SP2 true
#endif
#ifndef PG8_ALIGN
#define PG8_ALIGN true
#endif
__global__ void __launch_bounds__(NWAVES * 64, 2) fwd_kernel(Args args) {
    extern __shared__ __attribute__((aligned(16))) unsigned char lds[];
    Frame F;
    F.lds = (LAS unsigned char*)lds;
    F.MISC = (volatile LAS unsigned*)(F.lds + MISC_OFF);
    F.tid = threadIdx.x; F.lane = F.tid & 63; F.wave = __builtin_amdgcn_readfirstlane(F.tid >> 6);
    F.G = gridDim.x; { const int bx = blockIdx.x; F.vcu = (F.G % 8 == 0) ? (bx % 8) * (F.G / 8) + bx / 8 : bx; }
    F.ws = args.ws; F.in = args.in; F.out = args.out;
    F.ctl = (gu32*)(F.ws + WS_CTL);
    for (int u = F.tid; u < (LDS_BYTES - LDSCTL_OFF) / 4; u += NWAVES * 64) ((LAS unsigned*)(F.lds + LDSCTL_OFF))[u] = 0u;
    __syncthreads();
    XcdBarrier bar; bar.bar = (unsigned*)(F.ctl + CW_BAR); bar.x = 0; bar.st = nullptr;
    if (N_LAUNCHES == 1) bar = xcd_barrier_post((unsigned*)(F.ctl + CW_BAR), F.MISC + 8);
#define GRID_BAR() do { if (N_LAUNCHES == 1) xcd_barrier(bar); } while (0)
    const int lo = args.ph_lo, hi = args.ph_hi;
#ifdef TPROBE
#ifndef TPQ
#define TPQ 100.0f
#endif
    unsigned long long tp0_ = 0, tp1_ = 0;
#define TP_BEGIN(k) do { if (TPROBE == (k)) tp0_ = __builtin_amdgcn_s_memrealtime(); } while (0)
#define TP_END(k) do { if (TPROBE == (k)) tp1_ = __builtin_amdgcn_s_memrealtime(); } while (0)
#else
#define TP_BEGIN(k)
#define TP_END(k)
#endif
#ifndef PH_MASK
#define PH_MASK 0xFFFF
#endif
#define IN(k) (((PH_MASK >> (k)) & 1) && lo <= (k) && (k) < hi)
#define BOTH(k) (IN(k) && IN((k) + 1))

#ifndef PH_TWICE
#define PH_TWICE -1
#endif
#define TWICE(k, ...) do { __VA_ARGS__; if (PH_TWICE == (k)) { GRID_BAR(); __VA_ARGS__; } } while (0)
    TP_END(-1); TP_BEGIN(0);
    if (IN(0)) { TWICE(0, p0_prologue(F); p0_router_weights_bf16(F)); if (BOTH(0)) GRID_BAR(); }

    TP_END(0); TP_BEGIN(1);
    if (IN(1)) {
        p1_filter_expand(F);
        TWICE(1,
        { DenseSrc S; S.set(WSP(bf16, WS_XB), WSP(bf16, WS_WIN), M, UTR, DM, F.G, (int)blockIdx.x);
          EpiUT E{WSP(bf16, WS_UT), WSP(float, WS_RSX)};
          pg8::gemm_phase<EpiUT, DenseSrc, false, false, PG8_ALIGN, PG8_SP2>(F.lds + RING_OFF, DM, S, E); }
        { DenseSrc S; S.set(WSP(bf16, WS_XB), WSP(bf16, WS_WIN) + (size_t)UTR * DM, M, 1024, DM, F.G, (int)blockIdx.x);
          EpiQK E{WSP(bf16, WS_Q), WSP(bf16, WS_K), WSP(float, WS_RSX)};
          pg8::gemm_phase<EpiQK, DenseSrc, true, false, PG8_ALIGN, PG8_SP2>(F.lds + RING_OFF, DM, S, E); });
        if (BOTH(1)) GRID_BAR();
    }

    TP_END(1); TP_BEGIN(2);
    if (IN(2)) { TWICE(20, hyena_phase(F); __syncthreads()); TWICE(21, natten_phase(F)); if (BOTH(2)) GRID_BAR(); }

    TP_END(2); TP_BEGIN(3);
    if (IN(3)) { TWICE(3, mixnorm(F)); if (BOTH(3)) GRID_BAR();
#ifdef EXTRA_BAR
        for (int xb_ = 0; xb_ < EXTRA_BAR; ++xb_) GRID_BAR();
#endif
    }

    TP_END(3); TP_BEGIN(4);
    if (IN(4)) {
        TWICE(4, {
        DenseSrc S; S.set(WSP(bf16, WS_MIX), WSP(bf16, WS_WOUT), M, DM, DM, F.G, (int)blockIdx.x);
        EpiH1 E{WSP(bf16, WS_H1), WSP(bf16, WS_XB)};
        pg8::gemm_phase<EpiH1, DenseSrc, true, false, PG8_ALIGN, PG8_SP2>(F.lds + RING_OFF, DM, S, E); });
        if (BOTH(4)) GRID_BAR();
    }

    TP_END(4); TP_BEGIN(5);
    if (IN(5)) { router_phase(F); if (BOTH(5)) GRID_BAR(); }

    TP_END(5); TP_BEGIN(6);
    if (IN(6)) { TWICE(6, moe_phase_a(F)); if (BOTH(6)) GRID_BAR(); }

    TP_END(6); TP_BEGIN(7);
    if (IN(7)) { TWICE(7, moe_phase_b(F)); if (BOTH(7)) GRID_BAR(); }

    TP_END(7); TP_BEGIN(8);
    if (IN(8)) {
        TWICE(80, combine(F));
        __syncthreads();
        TWICE(81, {
        DenseSrc S; S.set(WSP(bf16, WS_PB), WSP(bf16, WS_WP), M, DM, PLE, F.G, (int)blockIdx.x);
        EpiPL E{WSP(bf16, WS_PL)};
        pg8::gemm_phase<EpiPL, DenseSrc, true, false, PG8_ALIGN, PG8_SP2>(F.lds + RING_OFF, PLE, S, E); });
        if (BOTH(8)) GRID_BAR();
    }

    TP_END(8); TP_BEGIN(9);
    if (IN(9)) {
        TWICE(9, {
        DenseSrc S; S.set(WSP(bf16, WS_H2), WSP(bf16, WS_WG), M, DM, DM, F.G, (int)blockIdx.x);
        EpiPLE E{WSP(bf16, WS_H3), WSP(bf16, WS_H2), WSP(bf16, WS_PL), WSP(float, WS_RS2)};
        pg8::gemm_phase<EpiPLE, DenseSrc, true, false, PG8_ALIGN, PG8_SP2>(F.lds + RING_OFF, DM, S, E); });
        if (BOTH(9)) GRID_BAR();
    }

    TP_END(9); TP_BEGIN(10);
    if (IN(10)) { TWICE(10, final_norm(F)); }
    TP_END(10);
#ifdef TPROBE
    if (blockIdx.x == 0 && F.tid == 0) { __builtin_amdgcn_s_waitcnt(0); F.out[0] = TPQ * floorf((float)(tp1_ - tp0_) * 0.01f * (1.0f / TPQ)); }
#endif
#undef IN
#undef BOTH
}

extern "C" void kernel_launch(void* const* d_in, const int* in_sizes, int n_in, void* d_out, int out_size, void* d_ws, size_t ws_size, hipStream_t stream) {
    static int grid = 0;
    if (grid == 0) {
        if (n_in != 30 || in_sizes[0] != M * DM || out_size != M * DM || ws_size < WS_END) { fprintf(stderr, "kernel_launch: unexpected shapes (n_in %d, in0 %d, out %d, ws %zu); nothing launched\n", n_in, n_in > 0 ? in_sizes[0] : -1, out_size, ws_size); grid = -1; return; }
        int dev = 0, cus = 0, per_cu = 0;
        if (hipGetDevice(&dev) != hipSuccess || hipDeviceGetAttribute(&cus, hipDeviceAttributeMultiprocessorCount, dev) != hipSuccess) { fprintf(stderr, "kernel_launch: device query failed\n"); grid = -1; return; }
        if (hipFuncSetAttribute((const void*)fwd_kernel, hipFuncAttributeMaxDynamicSharedMemorySize, LDS_BYTES) != hipSuccess) { fprintf(stderr, "kernel_launch: hipFuncSetAttribute failed\n"); grid = -1; return; }
        if (hipOccupancyMaxActiveBlocksPerMultiprocessor(&per_cu, (const void*)fwd_kernel, NWAVES * 64, LDS_BYTES) != hipSuccess || per_cu < 1) { fprintf(stderr, "kernel_launch: occupancy query reports %d\n", per_cu); }
        (void)hipGetLastError();
        grid = cus;
    }
    if (grid < 0) return;
    if (hipMemsetAsync((char*)d_ws + WS_CTL, 0, CTL_ZERO_BYTES, stream) != hipSuccess) { fprintf(stderr, "kernel_launch: memset failed\n"); return; }
    Args a{};
    for (int i = 0; i < 30; ++i) a.in[i] = (const float*)d_in[i];
    a.out = (float*)d_out; a.ws = (unsigned char*)d_ws;
    if (N_LAUNCHES == 1) {
        a.ph_lo = 0; a.ph_hi = N_PHASES;
        hipLaunchKernelGGL(fwd_kernel, dim3(grid), dim3(NWAVES * 64), LDS_BYTES, stream, a);
    } else {
        for (int li = 0; li < N_PHASES; ++li) {
#if MOE_NAIVE
            if (li == 7) continue;
#endif
            a.ph_lo = li; a.ph_hi = li + 1;
            hipLaunchKernelGGL(fwd_kernel, dim3(grid), dim3(NWAVES * 64), LDS_BYTES, stream, a);
        }
    }
    const hipError_t le = hipPeekAtLastError();
    if (le != hipSuccess) fprintf(stderr, "kernel_launch: launch failed: %s\n", hipGetErrorName(le));
}
```
